# Optimizing an MI355X kernel written in HIP

```python
import jax, jax.numpy as jnp
from jax import lax
import numpy as np

D_MODEL = 2048
BATCH = 4
SEQ = 2048
DEPTH = 2

HEAD_DIM = 128
N_MIX_HEADS = D_MODEL // HEAD_DIM
A_HEADS = N_MIX_HEADS // 4
B_HEADS = (N_MIX_HEADS - A_HEADS) // 2
C_HEADS = N_MIX_HEADS - A_HEADS - B_HEADS
C_KV_HEADS = 2
A_KEY_DIM = 128
A_CHUNK = 16
DILATED_PATTERNS = ((128, 1), (512, 4), (2048, 16))
C_WINDOW = 128
BLOCK = 128
ROPE_THETA = 500000.0
ROPE_DIM = HEAD_DIM // 4
D_FF = 5632
CONV_WIDTH = 3
LN_EPS = 1e-5
ALPHA = (2 * DEPTH) ** 0.25
BETA = (8 * DEPTH) ** -0.25

A_KEY_WIDTH = A_HEADS * A_KEY_DIM
A_WIDTH = A_HEADS * HEAD_DIM
B_WIDTH = B_HEADS * HEAD_DIM
C_WIDTH = C_HEADS * HEAD_DIM
C_KV_WIDTH = C_KV_HEADS * HEAD_DIM
MIX_WIDTH = A_WIDTH + B_WIDTH + C_WIDTH
PROJ_SIZES = (A_KEY_WIDTH, A_KEY_WIDTH, A_WIDTH, A_WIDTH,
              B_WIDTH, B_WIDTH, B_WIDTH,
              C_WIDTH, C_KV_WIDTH, C_KV_WIDTH)
VALUE_BLOCKS = (2, 6, 9)
IN_WIDTH = sum(PROJ_SIZES)

kernel_name = "hybrid_hgrn2_dilated_swa_sink_convffn"


def layer_norm(x, g, b):
    xf = x.astype(jnp.float32)
    mu = jnp.mean(xf, -1, keepdims=True)
    var = jnp.mean(jnp.square(xf - mu), -1, keepdims=True)
    return ((xf - mu) * lax.rsqrt(var + LN_EPS) * g.astype(jnp.float32) + b.astype(jnp.float32)).astype(x.dtype)


def rms_norm(x, g):
    xf = x.astype(jnp.float32)
    return xf * lax.rsqrt(jnp.mean(jnp.square(xf), -1, keepdims=True) + LN_EPS) * g.astype(jnp.float32)


def rope_tables(seq):
    inv = ROPE_THETA ** (-jnp.arange(0, ROPE_DIM, 2, dtype=jnp.float32) / ROPE_DIM)
    ang = jnp.arange(seq, dtype=jnp.float32)[:, None] * inv[None, :]
    return jnp.cos(ang), jnp.sin(ang)


def partial_rope(x, cos, sin):
    half = ROPE_DIM // 2
    xr = x[..., :ROPE_DIM].astype(jnp.float32)
    x1, x2 = xr[..., :half], xr[..., half:]
    rot = jnp.concatenate([x1 * cos - x2 * sin, x2 * cos + x1 * sin], -1)
    return jnp.concatenate([rot.astype(x.dtype), x[..., ROPE_DIM:]], -1)


def banded_attention(q, k, v, max_lag, sink=None):
    b, h, L, dh = q.shape
    nb = -(-L // BLOCK)
    pad = nb * BLOCK - L
    padw = ((0, 0), (0, 0), (0, pad), (0, 0))
    qb = jnp.pad(q, padw).reshape(b, h, nb, BLOCK, dh)
    kb = jnp.pad(k, padw).reshape(b, h, nb, BLOCK, dh)
    vb = jnp.pad(v, padw).reshape(b, h, nb, BLOCK, dh)
    shift = ((0, 0), (0, 0), (1, 0), (0, 0), (0, 0))
    kk = jnp.concatenate([jnp.pad(kb, shift)[:, :, :-1], kb], axis=3)
    vv = jnp.concatenate([jnp.pad(vb, shift)[:, :, :-1], vb], axis=3)
    s = jnp.einsum('bhnqd,bhnkd->bhnqk', qb, kk, preferred_element_type=jnp.float32) * (dh ** -0.5)
    r = jnp.arange(BLOCK)[:, None]
    c = jnp.arange(2 * BLOCK)[None, :]
    lag = BLOCK + r - c
    kpos = (jnp.arange(nb)[:, None, None] - 1) * BLOCK + c[None]
    valid = ((lag >= 0) & (lag <= max_lag))[None] & (kpos >= 0)
    s = jnp.where(valid, s, -jnp.inf)
    m = jnp.max(s, -1)
    if sink is not None:
        sk = sink.astype(jnp.float32)[None, :, None, None]
        m = jnp.maximum(m, sk)
    e = jnp.exp(s - m[..., None])
    denom = jnp.sum(e, -1)
    if sink is not None:
        denom = denom + jnp.exp(sk - m)
    out = jnp.einsum('bhnqk,bhnkd->bhnqd', e, vv.astype(jnp.float32)) / denom[..., None]
    lse = m + jnp.log(denom)
    out = out.reshape(b, h, nb * BLOCK, dh)[:, :, :L].astype(q.dtype)
    return out, lse.reshape(b, h, nb * BLOCK)[:, :, :L]


def dilated_attention(q, k, v):
    b, h, S, dh = q.shape
    outs, lses = [], []
    for window, dil in DILATED_PATTERNS:
        L = S // dil
        def split(t):
            return t.reshape(b, h, L, dil, dh).transpose(0, 1, 3, 2, 4).reshape(b, h * dil, L, dh)
        o, lse = banded_attention(split(q), split(k), split(v), window // dil)
        outs.append(o.reshape(b, h, dil, L, dh).transpose(0, 1, 3, 2, 4).reshape(b, h, S, dh))
        lses.append(lse.reshape(b, h, dil, L).transpose(0, 1, 3, 2).reshape(b, h, S))
    w = jax.nn.softmax(jnp.stack(lses, 0), axis=0)
    out = jnp.einsum('pbhs,pbhsd->bhsd', w, jnp.stack(outs, 0).astype(jnp.float32))
    return out.astype(q.dtype)


def hgrn2(q, f_logit, i, g, lb, norm_w):
    b, S, _ = q.shape
    n = S // A_CHUNK
    def chunks(t, dim):
        return t.astype(jnp.float32).reshape(b, n, A_CHUNK, A_HEADS, dim).transpose(0, 3, 1, 2, 4)
    qc = jax.nn.silu(chunks(q, A_KEY_DIM))
    fg = lb.astype(jnp.float32).reshape(A_HEADS, 1, 1, A_KEY_DIM) + \
        (1.0 - lb.astype(jnp.float32).reshape(A_HEADS, 1, 1, A_KEY_DIM)) * jax.nn.sigmoid(chunks(f_logit, A_KEY_DIM))
    kc = 1.0 - fg
    vc = chunks(i, HEAD_DIM)
    bcum = jnp.cumsum(jnp.log(fg), axis=3)
    causal = jnp.tril(jnp.ones((A_CHUNK, A_CHUNK), dtype=bool))
    diff = bcum[:, :, :, :, None, :] - bcum[:, :, :, None, :, :]
    decay = jnp.exp(jnp.where(causal[:, :, None], diff, -jnp.inf))
    att = jnp.einsum('bhnik,bhnjk,bhnijk->bhnij', qc, kc, decay)
    o_intra = jnp.einsum('bhnij,bhnjv->bhniv', att, vc)
    blast = bcum[:, :, :, -1:, :]
    upd = jnp.einsum('bhnck,bhncv->bhnkv', kc * jnp.exp(blast - bcum), vc)
    cdec = jnp.exp(blast[:, :, :, 0, :])
    def step(state, inp):
        dec, u = inp
        return dec[..., None] * state + u, state
    s0 = jnp.zeros((b, A_HEADS, A_KEY_DIM, HEAD_DIM), jnp.float32)
    _, s_prev = lax.scan(step, s0, (jnp.moveaxis(cdec, 2, 0), jnp.moveaxis(upd, 2, 0)))
    s_prev = jnp.moveaxis(s_prev, 0, 2)
    o_inter = jnp.einsum('bhnck,bhnkv->bhncv', qc * jnp.exp(bcum), s_prev)
    o = (o_intra + o_inter).transpose(0, 2, 3, 1, 4).reshape(b, S, A_HEADS, HEAD_DIM)
    o = rms_norm(o, norm_w).reshape(b, S, A_WIDTH)
    return (o * jax.nn.silu(g.astype(jnp.float32))).astype(q.dtype)


def mixer_sublayer(x, w_in, lb, a_norm_w, c_sink, w_out, cos, sin):
    b, S, _ = x.shape
    proj = x @ w_in
    idx = [int(t) for t in np.cumsum(PROJ_SIZES)[:-1]]
    qA, fA, iA, gA, qB, kB, vB, qC, kC, vC = jnp.split(proj, idx, axis=-1)
    def heads(t, nh):
        return t.reshape(b, S, nh, HEAD_DIM).transpose(0, 2, 1, 3)
    def merge(t):
        return t.transpose(0, 2, 1, 3).reshape(b, S, -1)
    oA = hgrn2(qA, fA, iA, gA, lb, a_norm_w)
    oB = dilated_attention(partial_rope(heads(qB, B_HEADS), cos, sin),
                           partial_rope(heads(kB, B_HEADS), cos, sin), heads(vB, B_HEADS))
    rep = C_HEADS // C_KV_HEADS
    kCh = jnp.repeat(partial_rope(heads(kC, C_KV_HEADS), cos, sin), rep, axis=1)
    vCh = jnp.repeat(heads(vC, C_KV_HEADS), rep, axis=1)
    oC, _ = banded_attention(partial_rope(heads(qC, C_HEADS), cos, sin), kCh, vCh, C_WINDOW - 1, c_sink)
    mixed = jnp.concatenate([oA, merge(oB), merge(oC)], axis=-1)
    return mixed @ w_out


def conv_ffn(x, w_gate, w_up, conv_w, conv_b, w_down):
    S = x.shape[1]
    g = x @ w_gate
    u = x @ w_up
    gp = jnp.pad(g, ((0, 0), (CONV_WIDTH - 1, 0), (0, 0)))
    gc = conv_b
    for j in range(CONV_WIDTH):
        gc = gc + conv_w[j] * gp[:, j:j + S]
    return (jax.nn.silu(gc) * u) @ w_down


def setup_inputs(seed: int = 0) -> dict:
    key = jax.random.key(seed)
    ks = jax.random.split(key, 24)
    f32 = jnp.float32
    x = jax.random.normal(ks[0], (BATCH, SEQ, D_MODEL), f32)
    blocks = []
    for j, size in enumerate(PROJ_SIZES):
        w = jax.random.normal(ks[1 + j], (DEPTH, D_MODEL, size), f32) * D_MODEL ** -0.5
        if j in VALUE_BLOCKS:
            w = w * BETA
        blocks.append(w)
    w_in = jnp.concatenate(blocks, axis=-1)
    lb_logits = jax.random.normal(ks[11], (DEPTH, A_KEY_WIDTH), f32)
    a_norm_w = 1.0 + 0.02 * jax.random.normal(ks[12], (DEPTH, HEAD_DIM), f32)
    c_sinks = jax.random.normal(ks[13], (DEPTH, C_HEADS), f32)
    w_out = jax.random.normal(ks[14], (DEPTH, MIX_WIDTH, D_MODEL), f32) * (MIX_WIDTH ** -0.5) * BETA
    ln1_g = 1.0 + 0.02 * jax.random.normal(ks[15], (DEPTH, D_MODEL), f32)
    ln1_b = 0.02 * jax.random.normal(ks[16], (DEPTH, D_MODEL), f32)
    w_gate = jax.random.normal(ks[17], (DEPTH, D_MODEL, D_FF), f32) * D_MODEL ** -0.5
    w_up = jax.random.normal(ks[18], (DEPTH, D_MODEL, D_FF), f32) * (D_MODEL ** -0.5) * BETA
    conv_w = jax.random.normal(ks[19], (DEPTH, CONV_WIDTH, D_FF), f32) * CONV_WIDTH ** -0.5
    conv_b = 0.02 * jax.random.normal(ks[20], (DEPTH, D_FF), f32)
    w_down = jax.random.normal(ks[21], (DEPTH, D_FF, D_MODEL), f32) * (D_FF ** -0.5) * BETA
    ln2_g = 1.0 + 0.02 * jax.random.normal(ks[22], (DEPTH, D_MODEL), f32)
    ln2_b = 0.02 * jax.random.normal(ks[23], (DEPTH, D_MODEL), f32)
    return {"x": x, "w_in": w_in, "lb_logits": lb_logits, "a_norm_w": a_norm_w, "c_sinks": c_sinks,
            "w_out": w_out, "ln1_g": ln1_g, "ln1_b": ln1_b, "w_gate": w_gate, "w_up": w_up,
            "conv_w": conv_w, "conv_b": conv_b, "w_down": w_down, "ln2_g": ln2_g, "ln2_b": ln2_b}


def reference(x, w_in, lb_logits, a_norm_w, c_sinks, w_out, ln1_g, ln1_b, w_gate, w_up,
              conv_w, conv_b, w_down, ln2_g, ln2_b):
    cos, sin = rope_tables(x.shape[1])
    lbs = jnp.cumsum(jax.nn.softmax(lb_logits.astype(jnp.float32), axis=0), axis=0)
    lbs = lbs - lbs[0]
    for l in range(DEPTH):
        y = mixer_sublayer(x, w_in[l], lbs[l], a_norm_w[l], c_sinks[l], w_out[l], cos, sin)
        x = layer_norm(ALPHA * x + y, ln1_g[l], ln1_b[l])
        y = conv_ffn(x, w_gate[l], w_up[l], conv_w[l], conv_b[l], w_down[l])
        x = layer_norm(ALPHA * x + y, ln2_g[l], ln2_b[l])
    return x
```

```cpp
#include <hip/hip_runtime.h>
#include <hip/hip_cooperative_groups.h>
#include <cstdio>
#include <cstdint>
namespace cg = cooperative_groups;
namespace pg8 {
#define PG8_LAS __attribute__((address_space(3)))
typedef unsigned short bf16_t;
typedef short bf16x8 __attribute__((ext_vector_type(8)));
typedef float f32x4 __attribute__((ext_vector_type(4)));
typedef unsigned u32x4 __attribute__((ext_vector_type(4)));
constexpr int BM = 256, BK = 64, HALF = 128, HTB = HALF * BK * 2  , STAGE_BYTES = 8 * HTB, NXCD = 8, WGM = 8;

__host__ __device__ __forceinline__ int lds_byte(int r, int c) { const int st = (r >> 4) * 2 + (c >> 5), rr = r & 15, cc = c & 31, ob = rr * 64 + cc * 2; return st * 1024 + (ob ^ (((ob >> 9) & 1) << 5)); }
__host__ __device__ __forceinline__ void stage_rc(int b, int& R, int& C) { const int st = b / 1024, sb = b % 1024, swz = sb ^ (((sb >> 9) & 1) << 5); R = (st >> 1) * 16 + swz / 64; C = (st & 1) * 32 + (swz % 64) / 2; }
__host__ __device__ __forceinline__ int perm32(int rho) { const int n = rho >> 4, i = rho & 15; return 8 * (i >> 2) + 4 * n + (i & 3); }

struct Unit { int pm, pn; };

struct StaticOrder {
    int nM, nN, nwg, G, c;
    __host__ __device__ void init(int M, int N, int G_, int c_) { nM = M / BM; nN = N / BM; nwg = nM * nN; G = G_; c = c_; }
    __host__ __device__ bool next(int i, Unit& u) const {
        const long L = (long)i * G + c; if (L >= nwg) return false;
        int wgid = (int)L; { const int q = nwg / NXCD, r = nwg % NXCD, xcd = wgid % NXCD, off = wgid / NXCD; wgid = (xcd < r ? xcd * (q + 1) : r * (q + 1) + (xcd - r) * q) + off; }
        const int nig = WGM * nN, gid = wgid / nig, fm = gid * WGM, gsz = (nM - fm) < WGM ? (nM - fm) : WGM;
        u.pm = fm + ((wgid % nig) % gsz); u.pn = (wgid % nig) / gsz; return true;
    }
    __device__ __forceinline__ void a_ready(const Unit&) const {}
    __device__ __forceinline__ void done(const Unit&) const {}
};

struct Gemm { const bf16_t* A; const bf16_t* Bt; int M, N, K, lda; };
__device__ __forceinline__ unsigned cvt_pk_bf16(float lo, float hi) { unsigned r; asm volatile("v_cvt_pk_bf16_f32 %0, %1, %2" : "=v"(r) : "v"(lo), "v"(hi)); return r; }

struct EpiStore {
    static constexpr bool PERM = true, AFTER_DRAIN = false;
    bf16_t* O; int ldc;
    __device__ __forceinline__ void operator()(const f32x4 (&acc)[2][2][4][2], const Unit& u, int wr, int wc, int fr, int fq) const {
        const int row0 = u.pm * BM + wr * 64 + fr; const int col0 = u.pn * BM + wc * 32 + 8 * fq;
#pragma unroll
        for (int ai = 0; ai < 2; ++ai)
#pragma unroll
            for (int m = 0; m < 4; ++m) { bf16_t* rowp = O + (size_t)(row0 + ai * HALF + m * 16) * ldc + col0;
#pragma unroll
                for (int bj = 0; bj < 2; ++bj) { const f32x4 v0 = acc[ai][bj][m][0], v1 = acc[ai][bj][m][1];
                    u32x4 w; w.x = cvt_pk_bf16(v0[0], v0[1]); w.y = cvt_pk_bf16(v0[2], v0[3]); w.z = cvt_pk_bf16(v1[0], v1[1]); w.w = cvt_pk_bf16(v1[2], v1[3]);
                    *(u32x4*)(rowp + bj * HALF) = w; } }
    }
};
struct EpiProj {
    static constexpr bool PERM = true, AFTER_DRAIN = false;
    bf16_t* O; int ldc; const float* rope;
    __device__ __forceinline__ void operator()(const f32x4 (&acc)[2][2][4][2], const Unit& u, int wr, int wc, int fr, int fq) const {
        const int row0 = u.pm * BM + wr * 64 + fr; const int col0 = u.pn * BM + wc * 32 + 8 * fq;
        bool rp[2];
#pragma unroll
        for (int bj = 0; bj < 2; ++bj) { const int cb = u.pn * BM + bj * HALF; rp[bj] = (wc == 0) && ((cb >= 2048 && cb < 3584) || (cb >= 4352 && cb < 5376)); }
        const bool anyr = rp[0] || rp[1];
        const float sgn = (fq < 2) ? -1.f : 1.f;
#pragma unroll
        for (int ai = 0; ai < 2; ++ai)
#pragma unroll
            for (int m = 0; m < 4; ++m) { const int row = row0 + ai * HALF + m * 16; bf16_t* rowp = O + (size_t)row * ldc + col0;
                f32x4 c0 = {1.f, 1.f, 1.f, 1.f}, c1 = c0, s0 = {0.f, 0.f, 0.f, 0.f}, s1 = s0;
                if (anyr) { const float* rt = rope + (size_t)(row & 2047) * 32 + 8 * (fq & 1);
                    c0 = *(const f32x4*)(rt); c1 = *(const f32x4*)(rt + 4); s0 = *(const f32x4*)(rt + 16); s1 = *(const f32x4*)(rt + 20); }
#pragma unroll
                for (int bj = 0; bj < 2; ++bj) { f32x4 v0 = acc[ai][bj][m][0], v1 = acc[ai][bj][m][1];
                    if (rp[bj]) {
                        f32x4 p0, p1;
#pragma unroll
                        for (int i = 0; i < 4; ++i) { p0[i] = __shfl_xor(v0[i], 32); p1[i] = __shfl_xor(v1[i], 32); }
                        v0 = v0 * c0 + (p0 * s0) * sgn; v1 = v1 * c1 + (p1 * s1) * sgn;
                    }
                    u32x4 w; w.x = cvt_pk_bf16(v0[0], v0[1]); w.y = cvt_pk_bf16(v0[2], v0[3]); w.z = cvt_pk_bf16(v1[0], v1[1]); w.w = cvt_pk_bf16(v1[2], v1[3]);
                    *(u32x4*)(rowp + bj * HALF) = w; } }
    }
};
struct EpiZ {
    static constexpr bool PERM = false, AFTER_DRAIN = false;
    const float* res; float* Z; float alpha;
    __device__ __forceinline__ void operator()(const f32x4 (&acc)[2][2][4][2], const Unit& u, int wr, int wc, int fr, int fq) const {
        const int col0 = u.pn * BM + wc * 32 + 4 * fq;
#pragma unroll
        for (int ai = 0; ai < 2; ++ai)
#pragma unroll
            for (int m = 0; m < 4; ++m) { const int r = u.pm * BM + ai * HALF + wr * 64 + m * 16 + fr; const size_t off = (size_t)r * 2048 + col0;
#pragma unroll
                for (int bj = 0; bj < 2; ++bj)
#pragma unroll
                    for (int n = 0; n < 2; ++n) { const f32x4 bs = *(const f32x4*)(res + off + bj * HALF + n * 16); const f32x4 o = bs * alpha + acc[ai][bj][m][n]; *(f32x4*)(Z + off + bj * HALF + n * 16) = o; } }
    }
};
template <class Epi, class Sched, bool ALIGN_EPI = false, bool SP2 = false>
__device__ __forceinline__ void gemm_phase(PG8_LAS unsigned char* lds, const Gemm g, const Sched& S, const Epi& E) {
    int tid_ = threadIdx.x; asm volatile("" : "+v"(tid_));
    const int tid = tid_, wid = __builtin_amdgcn_readfirstlane(tid >> 6), lane = tid & 63, wr = wid >> 2, wc = wid & 3, fr = lane & 15, fq = lane >> 4;
    const int K = g.K, nt = K / BK, lda = g.lda;
    unsigned voffA[2], voffB[2];
#pragma unroll
    for (int i = 0; i < 2; ++i) { int R, C; stage_rc(tid * 16 + i * 8192, R, C); const int Rb = Epi::PERM ? ((R & ~31) + perm32(R & 31)) : R;
        voffA[i] = (unsigned)(R * lda + C) * 2u; voffB[i] = (unsigned)(Rb * K + C) * 2u; }
    const size_t kstep = (size_t)(BK * 2);
    const size_t hstep = (size_t)HALF * K * 2;
    const size_t tstep = 2 * hstep; const size_t hstepA = (size_t)HALF * lda * 2, tstepA = 2 * hstepA;
    const unsigned ldsw = (unsigned)wid * 1024u;
    const int aoff = lds_byte(wr * 64 + fr, fq * 8), boff = lds_byte(wc * 32 + fr, fq * 8);
#define PG8_SA(b, h) (((b) * 2 + (h)) * HTB)
#define PG8_SB(b, h) ((4 + (b) * 2 + (h)) * HTB)
#define PG8_STAGE(bufoff, gbase, voff) do { _Pragma("unroll") for (int _i = 0; _i < 2; ++_i) \
        __builtin_amdgcn_global_load_lds((const unsigned*)((const char*)(gbase) + (voff)[_i]), (PG8_LAS unsigned*)(lds + (bufoff) + ldsw + _i * 8192), 16, 0, 0); } while (0)
#define PG8_LDA(dst, b, h) do { _Pragma("unroll") for (int m = 0; m < 4; ++m) _Pragma("unroll") for (int k = 0; k < 2; ++k) dst[m][k] = *(const PG8_LAS bf16x8*)(lds + PG8_SA(b, h) + aoff + m * 2048 + k * 1024); } while (0)
#define PG8_LDB(dst, b, h) do { _Pragma("unroll") for (int n = 0; n < 2; ++n) _Pragma("unroll") for (int k = 0; k < 2; ++k) dst[n][k] = *(const PG8_LAS bf16x8*)(lds + PG8_SB(b, h) + boff + n * 2048 + k * 1024); } while (0)
#define PG8_MMA(ai, bj, At, Bt) do { __builtin_amdgcn_s_setprio(1); _Pragma("unroll") for (int m = 0; m < 4; ++m) _Pragma("unroll") for (int n = 0; n < 2; ++n) _Pragma("unroll") for (int k = 0; k < 2; ++k) \
        acc[ai][bj][m][n] = __builtin_amdgcn_mfma_f32_16x16x32_bf16(Bt[n][k], At[m][k], acc[ai][bj][m][n], 0, 0, 0); __builtin_amdgcn_s_setprio(0); } while (0)
#define PG8_WAIT_V(n) asm volatile("s_waitcnt vmcnt(" #n ")" ::: "memory")
#define PG8_WAIT_L(n) asm volatile("s_waitcnt lgkmcnt(" #n ")" ::: "memory")
#define PG8_BAR __builtin_amdgcn_s_barrier()
#define PG8_SCHED __builtin_amdgcn_sched_barrier(0)
    Unit cur, nxt; int ui = 0;
    if (!S.next(0, cur)) return;
    f32x4 acc[2][2][4][2];
#pragma unroll
    for (int a = 0; a < 2; ++a)
#pragma unroll
        for (int b = 0; b < 2; ++b)
#pragma unroll
            for (int m = 0; m < 4; ++m)
#pragma unroll
                for (int n = 0; n < 2; ++n) acc[a][b][m][n] = (f32x4){0.f, 0.f, 0.f, 0.f};
    bf16x8 At[4][2], B0[2][2], B1[2][2];
    const char* cA = (const char*)g.A + (size_t)cur.pm * tstepA; const char* cB = (const char*)g.Bt + (size_t)cur.pn * tstep;
    S.a_ready(cur);
    if constexpr (SP2) {
        PG8_STAGE(PG8_SB(0, 0), cB, voffB); PG8_STAGE(PG8_SB(0, 1), cB + hstep, voffB); PG8_STAGE(PG8_SA(0, 0), cA, voffA); PG8_STAGE(PG8_SA(0, 1), cA + hstepA, voffA);
        if (wr == 1) PG8_BAR;
        PG8_WAIT_V(2); PG8_BAR;
        PG8_STAGE(PG8_SB(1, 0), cB + kstep, voffB); PG8_STAGE(PG8_SA(1, 0), cA + kstep, voffA); PG8_STAGE(PG8_SB(1, 1), cB + hstep + kstep, voffB);
        PG8_WAIT_V(6); PG8_BAR;
    } else {
        PG8_STAGE(PG8_SB(0, 0), cB, voffB); PG8_STAGE(PG8_SA(0, 0), cA, voffA); PG8_STAGE(PG8_SB(0, 1), cB + hstep, voffB); PG8_STAGE(PG8_SA(0, 1), cA + hstepA, voffA);
        if (wr == 1) PG8_BAR;
        PG8_WAIT_V(4); PG8_BAR;
        PG8_STAGE(PG8_SB(1, 0), cB + kstep, voffB); PG8_STAGE(PG8_SA(1, 0), cA + kstep, voffA); PG8_STAGE(PG8_SB(1, 1), cB + hstep + kstep, voffB);
        PG8_WAIT_V(6); PG8_BAR;
    }
    for (;;) {
        const bool has_next = S.next(ui + 1, nxt);
        const char* nA = has_next ? (const char*)g.A + (size_t)nxt.pm * tstepA : cA; const char* nB = has_next ? (const char*)g.Bt + (size_t)nxt.pn * tstep : cB;
        for (int t = 0; t < nt; t += 2) {
            const bool last = (t == nt - 2);
            const char* a1 = cA + (size_t)(t + 1) * kstep;
            const char* a2 = last ? nA : cA + (size_t)(t + 2) * kstep; const char* b2 = last ? nB : cB + (size_t)(t + 2) * kstep;
            const char* a3 = a2 + kstep; const char* b3 = b2 + kstep;
            if (last && has_next) S.a_ready(nxt);
            if constexpr (SP2) {
            PG8_LDB(B0, 0, 0); PG8_LDB(B1, 0, 1); PG8_SCHED; PG8_LDA(At, 0, 0); PG8_STAGE(PG8_SA(1, 1), a1 + hstepA, voffA);
            PG8_WAIT_V(8); PG8_WAIT_L(0); PG8_BAR; PG8_MMA(0, 0, At, B0); PG8_MMA(0, 1, At, B1); PG8_BAR; PG8_SCHED;
            PG8_LDA(At, 0, 1); PG8_STAGE(PG8_SB(0, 0), b2, voffB); PG8_STAGE(PG8_SB(0, 1), b2 + hstep, voffB); PG8_STAGE(PG8_SA(0, 0), a2, voffA);
            PG8_WAIT_V(8); PG8_WAIT_L(0); PG8_BAR; PG8_MMA(1, 0, At, B0); PG8_MMA(1, 1, At, B1); PG8_BAR; PG8_SCHED;
            PG8_LDB(B0, 1, 0); PG8_LDB(B1, 1, 1); PG8_SCHED; PG8_LDA(At, 1, 0); PG8_STAGE(PG8_SA(0, 1), a2 + hstepA, voffA);
            PG8_WAIT_V(8); PG8_WAIT_L(0); PG8_BAR; PG8_MMA(0, 0, At, B0); PG8_MMA(0, 1, At, B1); PG8_BAR; PG8_SCHED;
            PG8_LDA(At, 1, 1); PG8_STAGE(PG8_SB(1, 0), b3, voffB); PG8_STAGE(PG8_SB(1, 1), b3 + hstep, voffB); PG8_STAGE(PG8_SA(1, 0), a3, voffA);
            PG8_WAIT_V(8); PG8_WAIT_L(0); PG8_BAR; PG8_MMA(1, 0, At, B0); PG8_MMA(1, 1, At, B1); PG8_BAR; PG8_SCHED;
            } else {
            PG8_LDB(B0, 0, 0); PG8_SCHED; PG8_LDA(At, 0, 0); PG8_STAGE(PG8_SA(1, 1), a1 + hstepA, voffA);
            PG8_WAIT_L(8); PG8_BAR; PG8_WAIT_L(0); PG8_MMA(0, 0, At, B0); PG8_BAR; PG8_SCHED;
            PG8_LDB(B1, 0, 1); PG8_STAGE(PG8_SB(0, 0), b2, voffB);
            PG8_BAR; PG8_WAIT_L(0); PG8_MMA(0, 1, At, B1); PG8_BAR;
            PG8_LDA(At, 0, 1); PG8_STAGE(PG8_SA(0, 0), a2, voffA);
            PG8_BAR; PG8_WAIT_L(0); PG8_MMA(1, 0, At, B0); PG8_BAR; PG8_SCHED;
            PG8_STAGE(PG8_SB(0, 1), b2 + hstep, voffB);
            PG8_WAIT_V(6); PG8_BAR; PG8_MMA(1, 1, At, B1); PG8_BAR;
            PG8_LDB(B0, 1, 0); PG8_SCHED; PG8_LDA(At, 1, 0); PG8_STAGE(PG8_SA(0, 1), a2 + hstepA, voffA);
            PG8_WAIT_L(8); PG8_BAR; PG8_WAIT_L(0); PG8_MMA(0, 0, At, B0); PG8_BAR; PG8_SCHED;
            PG8_LDB(B1, 1, 1); PG8_STAGE(PG8_SB(1, 0), b3, voffB);
            PG8_BAR; PG8_WAIT_L(0); PG8_MMA(0, 1, At, B1); PG8_BAR;
            PG8_LDA(At, 1, 1); PG8_STAGE(PG8_SA(1, 0), a3, voffA);
            PG8_BAR; PG8_WAIT_L(0); PG8_MMA(1, 0, At, B0); PG8_BAR; PG8_SCHED;
            PG8_STAGE(PG8_SB(1, 1), b3 + hstep, voffB);
            PG8_WAIT_V(6); PG8_BAR; PG8_MMA(1, 1, At, B1); PG8_BAR;
            }
        }
        if constexpr (ALIGN_EPI) { if (wr == 0) PG8_BAR; }
        if constexpr (!Epi::AFTER_DRAIN) { E(acc, cur, wr, wc, fr, fq); S.done(cur); }
        if (!has_next) break;
#pragma unroll
        for (int a = 0; a < 2; ++a)
#pragma unroll
            for (int b = 0; b < 2; ++b)
#pragma unroll
                for (int m = 0; m < 4; ++m)
#pragma unroll
                    for (int n = 0; n < 2; ++n) acc[a][b][m][n] = (f32x4){0.f, 0.f, 0.f, 0.f};
        cur = nxt; cA = nA; cB = nB; ++ui;
        if constexpr (ALIGN_EPI) { if (wr == 1) PG8_BAR; }
    }
    PG8_WAIT_V(0);
    if constexpr (!ALIGN_EPI) { if (wr == 0) PG8_BAR; }
    PG8_BAR;
    if constexpr (Epi::AFTER_DRAIN) { E.fused(acc, cur, wr, wc, fr, fq, lds, wid, lane); S.done(cur); }
#undef PG8_SA
#undef PG8_SB
#undef PG8_STAGE
#undef PG8_LDA
#undef PG8_LDB
#undef PG8_MMA
#undef PG8_WAIT_V
#undef PG8_WAIT_L
#undef PG8_BAR
#undef PG8_SCHED
}
}
#define LAS __attribute__((address_space(3)))
typedef unsigned short bf16_t;
typedef short bf16x8 __attribute__((ext_vector_type(8)));
typedef short bf16x4 __attribute__((ext_vector_type(4)));
typedef float f32x4 __attribute__((ext_vector_type(4)));
typedef unsigned u32x4 __attribute__((ext_vector_type(4)));
typedef unsigned u32x2 __attribute__((ext_vector_type(2)));
constexpr int M_TOK = 8192, SEQ = 2048, DM = 2048, INW = 5632, FF = 5632, GUW = 11264;
constexpr float ALPHA = 1.4142135623730951f, LN_EPS = 1e-5f;
constexpr size_t MiB = 1u << 20;
constexpr size_t WS_ROPE = 64 * 1024, WS_LBS = 320 * 1024;
constexpr size_t WS_WIN = 1 * MiB, WS_WOUT = 23 * MiB, WS_WGU = 31 * MiB, WS_WDN = 75 * MiB;
constexpr size_t WS_XB = 97 * MiB, WS_XRES = 129 * MiB, WS_R = 193 * MiB;
constexpr size_t WS_PROJ = WS_R, WS_MIXED = WS_R + 88 * MiB, WS_OBP = WS_R + 120 * MiB, WS_OA = WS_R + 156 * MiB, WS_LSE = WS_R + 172 * MiB;
constexpr size_t WS_GU = WS_R;
constexpr size_t WS_END = 448 * MiB;
constexpr int LDS_BYTES = 139264 + 1024;
constexpr int NWAVES = 8, NTHR = 512;

__device__ __forceinline__ float bf2f(unsigned short v) { return __uint_as_float((unsigned)v << 16); }
__device__ __forceinline__ unsigned f2bf(float f) { unsigned u = __float_as_uint(f); return (u + 0x7fffu + ((u >> 16) & 1u)) >> 16; }
__device__ __forceinline__ unsigned pk2(float lo, float hi) { return pg8::cvt_pk_bf16(lo, hi); }
__device__ __forceinline__ float wave_sum(float v) {
#pragma unroll
    for (int o = 1; o < 64; o <<= 1) v += __shfl_xor(v, o);
    return v;
}
#define LDS_WAIT() asm volatile("s_waitcnt lgkmcnt(0)" ::: "memory")

__device__ __forceinline__ void transpose_item(const float* W, int K, int N, bf16_t* WT, int row_off, LAS float* scr, int item, int lane) {
    const int nblk = N / 32, kb = item / nblk, nb = item % nblk, k0 = 64 * kb, n0 = 32 * nb;
#pragma unroll 8
    for (int i = 0; i < 32; ++i) { const int kk = 2 * i + (lane >> 5); scr[kk * 33 + (lane & 31)] = W[(size_t)(k0 + kk) * N + n0 + (lane & 31)]; }
    LDS_WAIT(); asm volatile("" ::: "memory");
    const int c = lane & 7;
#pragma unroll
    for (int j = 0; j < 4; ++j) { const int n = (lane >> 3) + 8 * j; const LAS float* s = scr + (8 * c) * 33 + n;
        u32x4 o; o.x = pk2(s[0 * 33], s[1 * 33]); o.y = pk2(s[2 * 33], s[3 * 33]); o.z = pk2(s[4 * 33], s[5 * 33]); o.w = pk2(s[6 * 33], s[7 * 33]);
        *(u32x4*)(WT + (size_t)(row_off + n0 + n) * K + k0 + 8 * c) = o; }
    LDS_WAIT(); asm volatile("" ::: "memory");
}

struct Ptrs {
    const float* in[15]; float* out; unsigned char* ws;
};

__device__ __forceinline__ void convert_weights(const Ptrs& P, int l, LAS unsigned char* lds, int gw, int NGW, int wave, int lane) {
    LAS float* scr = (LAS float*)(lds + wave * 16384);
    constexpr int I_IN = 32 * 176, I_OUT = 32 * 64, I_G = 32 * 176, I_D = 88 * 64;
    constexpr int NITEMS = I_IN + I_OUT + 2 * I_G + I_D;
    bf16_t* Win_t = (bf16_t*)(P.ws + WS_WIN); bf16_t* Wout_t = (bf16_t*)(P.ws + WS_WOUT); bf16_t* Wgu_t = (bf16_t*)(P.ws + WS_WGU); bf16_t* Wdn_t = (bf16_t*)(P.ws + WS_WDN);
    const float* w_in = P.in[1] + (size_t)l * DM * INW; const float* w_out = P.in[5] + (size_t)l * DM * DM;
    const float* w_gate = P.in[8] + (size_t)l * DM * FF; const float* w_up = P.in[9] + (size_t)l * DM * FF; const float* w_down = P.in[12] + (size_t)l * FF * DM;
    for (int it = gw; it < NITEMS; it += NGW) {
        int r = it;
        if (r < I_IN) { transpose_item(w_in, DM, INW, Win_t, 0, scr, r, lane); continue; } r -= I_IN;
        if (r < I_OUT) { transpose_item(w_out, DM, DM, Wout_t, 0, scr, r, lane); continue; } r -= I_OUT;
        if (r < I_G) { transpose_item(w_gate, DM, FF, Wgu_t, 0, scr, r, lane); continue; } r -= I_G;
        if (r < I_G) { transpose_item(w_up, DM, FF, Wgu_t, FF, scr, r, lane); continue; } r -= I_G;
        transpose_item(w_down, FF, DM, Wdn_t, 0, scr, r, lane);
    }
}

__device__ __forceinline__ void ln_row(const float* zrow, const float* gam, const float* bet, float* out_f, bf16_t* out_b, int lane) {
    f32x4 v[8]; float s = 0.f;
#pragma unroll
    for (int j = 0; j < 8; ++j) { v[j] = *(const f32x4*)(zrow + 4 * lane + 256 * j); s += (v[j][0] + v[j][1]) + (v[j][2] + v[j][3]); }
    const float mean = wave_sum(s) * (1.f / 2048.f); float s2 = 0.f;
#pragma unroll
    for (int j = 0; j < 8; ++j) { v[j] = v[j] - mean; s2 += (v[j][0] * v[j][0] + v[j][1] * v[j][1]) + (v[j][2] * v[j][2] + v[j][3] * v[j][3]); }
    const float rstd = 1.f / sqrtf(wave_sum(s2) * (1.f / 2048.f) + LN_EPS);
#pragma unroll
    for (int j = 0; j < 8; ++j) { const f32x4 gg = *(const f32x4*)(gam + 4 * lane + 256 * j), bb = *(const f32x4*)(bet + 4 * lane + 256 * j);
        const f32x4 o = v[j] * rstd * gg + bb;
        if (out_f) *(f32x4*)(out_f + 4 * lane + 256 * j) = o;
        if (out_b) { u32x2 w; w.x = pk2(o[0], o[1]); w.y = pk2(o[2], o[3]); *(u32x2*)(out_b + 4 * lane + 256 * j) = w; } }
}

__device__ __forceinline__ void attn_item(LAS unsigned char* lds, const bf16_t* proj, int b, int qcol, int kcol, int vcol, int dil, int res, int nb, int maxlag,
                                          bool hasSink, float sink, bf16_t* out, int ldo, int ocol, float* lsep, int tid, int wid, int lane) {
    constexpr int KROW = 272, VROW = 528;
    LAS unsigned char* Ks = lds; LAS unsigned char* Vs = lds + 256 * KROW;
    const int tk0 = (nb - 1) * 128;
#pragma unroll
    for (int i = 0; i < 8; ++i) { const int e = tid + 512 * i, key = e >> 4, ch = e & 15, tau = tk0 + key;
        u32x4 v = {0u, 0u, 0u, 0u};
        if (tau >= 0) v = *(const u32x4*)(proj + (size_t)(b * SEQ + tau * dil + res) * INW + kcol + ch * 8);
        *(LAS u32x4*)(Ks + key * KROW + ch * 16) = v; }
#pragma unroll
    for (int i = 0; i < 4; ++i) { const int e = tid + 512 * i, ch = (e & 1) | (((e >> 6) & 7) << 1), kp = ((e >> 1) & 31) | ((e >> 9) << 5), tau0 = tk0 + 2 * kp;
        u32x4 a = {0u, 0u, 0u, 0u}, c = {0u, 0u, 0u, 0u};
        if (tau0 >= 0) { a = *(const u32x4*)(proj + (size_t)(b * SEQ + tau0 * dil + res) * INW + vcol + ch * 8); c = *(const u32x4*)(proj + (size_t)(b * SEQ + (tau0 + 1) * dil + res) * INW + vcol + ch * 8); }
#pragma unroll
        for (int q = 0; q < 4; ++q) {
            *(LAS unsigned*)(Vs + (ch * 8 + 2 * q) * VROW + kp * 4) = (a[q] & 0xffffu) | (c[q] << 16);
            *(LAS unsigned*)(Vs + (ch * 8 + 2 * q + 1) * VROW + kp * 4) = (a[q] >> 16) | (c[q] & 0xffff0000u); } }
    __syncthreads();
    const int l15 = lane & 15, g = lane >> 4;
    const int r = 16 * wid + l15, tq = (nb * 128 + r) * dil + res; const size_t qrow = (size_t)b * SEQ + tq;
    bf16x8 Qf[4];
#pragma unroll
    for (int kk = 0; kk < 4; ++kk) Qf[kk] = *(const bf16x8*)(proj + qrow * INW + qcol + 32 * kk + 8 * g);
    f32x4 S[10];
#pragma unroll
    for (int i = 0; i < 10; ++i) { const int kt = wid + i, ktc = kt < 15 ? kt : 15; f32x4 acc = {0.f, 0.f, 0.f, 0.f};
#pragma unroll
        for (int kk = 0; kk < 4; ++kk) { const bf16x8 A = *(const LAS bf16x8*)(Ks + (16 * ktc + l15) * KROW + (32 * kk + 8 * g) * 2); acc = __builtin_amdgcn_mfma_f32_16x16x32_bf16(A, Qf[kk], acc, 0, 0, 0); }
        S[i] = acc; }
    const float scale = 0.08838834764831845f;
    float mx = -1e30f;
#pragma unroll
    for (int i = 0; i < 10; ++i)
#pragma unroll
        for (int j = 0; j < 4; ++j) { const int c = 16 * (wid + i) + 4 * g + j, lag = 128 + r - c; const bool valid = (wid + i < 16) && lag >= 0 && lag <= maxlag && (tk0 + c >= 0);
            const float s = valid ? S[i][j] * scale : -1e30f; S[i][j] = s; mx = fmaxf(mx, s); }
    mx = fmaxf(mx, __shfl_xor(mx, 16)); mx = fmaxf(mx, __shfl_xor(mx, 32));
    if (hasSink) mx = fmaxf(mx, sink);
    float sum = 0.f;
#pragma unroll
    for (int i = 0; i < 10; ++i)
#pragma unroll
        for (int j = 0; j < 4; ++j) { const float p = __expf(S[i][j] - mx); S[i][j] = p; sum += p; }
    sum += __shfl_xor(sum, 16); sum += __shfl_xor(sum, 32);
    if (hasSink) sum += __expf(sink - mx);
    bf16x8 Pf[5];
#pragma unroll
    for (int sl = 0; sl < 5; ++sl) { u32x4 w; w.x = pk2(S[2 * sl][0], S[2 * sl][1]); w.y = pk2(S[2 * sl][2], S[2 * sl][3]); w.z = pk2(S[2 * sl + 1][0], S[2 * sl + 1][1]); w.w = pk2(S[2 * sl + 1][2], S[2 * sl + 1][3]); Pf[sl] = __builtin_bit_cast(bf16x8, w); }
    const float inv = 1.f / sum;
#pragma unroll
    for (int dt = 0; dt < 8; ++dt) { f32x4 acc = {0.f, 0.f, 0.f, 0.f}; const int d = 16 * dt + l15;
#pragma unroll
        for (int sl = 0; sl < 5; ++sl) { const int k0 = (wid + 2 * sl) < 15 ? (wid + 2 * sl) : 15, k1 = (wid + 2 * sl + 1) < 15 ? (wid + 2 * sl + 1) : 15;
            const u32x2 lo = *(const LAS u32x2*)(Vs + d * VROW + (16 * k0 + 4 * g) * 2), hi = *(const LAS u32x2*)(Vs + d * VROW + (16 * k1 + 4 * g) * 2);
            u32x4 w; w.x = lo.x; w.y = lo.y; w.z = hi.x; w.w = hi.y;
            acc = __builtin_amdgcn_mfma_f32_16x16x32_bf16(__builtin_bit_cast(bf16x8, w), Pf[sl], acc, 0, 0, 0); }
        acc = acc * inv; u32x2 w; w.x = pk2(acc[0], acc[1]); w.y = pk2(acc[2], acc[3]);
        *(u32x2*)(out + qrow * ldo + ocol + 16 * dt + 4 * g) = w; }
    if (lsep && g == 0) lsep[qrow * 6] = mx + __logf(sum);
    __syncthreads();
}

constexpr int HG_QT = 0, HG_KH = 17408, HG_KT = 34816, HG_VT = 51200, HG_EB = 67584, HG_BUF = 69632;
__device__ __forceinline__ void hgrn_stage(LAS unsigned char* base, const bf16_t* proj, int b, int h, int r, float lbk, int tid) {
    const int k = tid & 127, chk = tid >> 7;
    const bf16_t* p = proj + (size_t)(b * SEQ + 64 * r + 16 * chk) * INW + h * 128 + k;
    float bc = 0.f; float kkv[16], bcv[16]; unsigned vt[16];
    LAS bf16_t* QT = (LAS bf16_t*)(base + HG_QT); LAS bf16_t* KH = (LAS bf16_t*)(base + HG_KH);
#pragma unroll
    for (int c = 0; c < 16; ++c) {
        const float qraw = bf2f(p[(size_t)c * INW]), fl = bf2f(p[(size_t)c * INW + 512]); vt[c] = p[(size_t)c * INW + 1024];
        const float sg = 1.f / (1.f + __expf(-fl)), f = lbk + (1.f - lbk) * sg;
        bc += __logf(f);
        const float kk = (1.f - lbk) / (1.f + __expf(fl));
        const float qh = qraw / (1.f + __expf(-qraw));
        QT[(16 * chk + c) * 136 + k] = (bf16_t)f2bf(qh * __expf(bc));
        KH[(16 * chk + c) * 136 + k] = (bf16_t)f2bf(kk * __expf(-bc));
        kkv[c] = kk; bcv[c] = bc; }
    u32x4 w0, w1, x0, x1;
#pragma unroll
    for (int c = 0; c < 4; ++c) { w0[c] = pk2(kkv[2 * c] * __expf(bc - bcv[2 * c]), kkv[2 * c + 1] * __expf(bc - bcv[2 * c + 1]));
        w1[c] = pk2(kkv[8 + 2 * c] * __expf(bc - bcv[8 + 2 * c]), kkv[8 + 2 * c + 1] * __expf(bc - bcv[8 + 2 * c + 1]));
        x0[c] = vt[2 * c] | (vt[2 * c + 1] << 16); x1[c] = vt[8 + 2 * c] | (vt[8 + 2 * c + 1] << 16); }
    *(LAS u32x4*)(base + HG_KT + (chk * 128 + k) * 32) = w0; *(LAS u32x4*)(base + HG_KT + (chk * 128 + k) * 32 + 16) = w1;
    *(LAS u32x4*)(base + HG_VT + (chk * 128 + k) * 32) = x0; *(LAS u32x4*)(base + HG_VT + (chk * 128 + k) * 32 + 16) = x1;
    *(LAS float*)(base + HG_EB + (chk * 128 + k) * 4) = __expf(bc);
}
__device__ __forceinline__ void hgrn_compute(LAS unsigned char* base, f32x4 (&S)[8], float* oA, int b, int h, int r, int wid, int lane) {
    const int l15 = lane & 15, g = lane >> 4;
#pragma unroll 1
    for (int ch = 0; ch < 4; ++ch) {
        bf16x8 Qf[4], Kf[4];
#pragma unroll
        for (int p = 0; p < 4; ++p) { const int off = ((16 * ch + l15) * 136 + 32 * p + 4 * g) * 2;
            const u32x2 a = *(const LAS u32x2*)(base + HG_QT + off), a2 = *(const LAS u32x2*)(base + HG_QT + off + 32);
            const u32x2 c = *(const LAS u32x2*)(base + HG_KH + off), c2 = *(const LAS u32x2*)(base + HG_KH + off + 32);
            u32x4 w; w.x = a.x; w.y = a.y; w.z = a2.x; w.w = a2.y; Qf[p] = __builtin_bit_cast(bf16x8, w);
            w.x = c.x; w.y = c.y; w.z = c2.x; w.w = c2.y; Kf[p] = __builtin_bit_cast(bf16x8, w); }
        f32x4 att = {0.f, 0.f, 0.f, 0.f};
#pragma unroll
        for (int p = 0; p < 4; ++p) att = __builtin_amdgcn_mfma_f32_16x16x32_bf16(Kf[p], Qf[p], att, 0, 0, 0);
#pragma unroll
        for (int j = 0; j < 4; ++j) att[j] = (4 * g + j <= l15) ? att[j] : 0.f;
        u32x2 aw; aw.x = pk2(att[0], att[1]); aw.y = pk2(att[2], att[3]);
        const bf16x4 attA = __builtin_bit_cast(bf16x4, aw);
        const bf16x4 Vf = __builtin_bit_cast(bf16x4, *(const LAS u32x2*)(base + HG_VT + (ch * 128 + 16 * wid + l15) * 32 + 8 * g));
        f32x4 o = {0.f, 0.f, 0.f, 0.f};
        o = __builtin_amdgcn_mfma_f32_16x16x16bf16_1k(attA, Vf, o, 0, 0, 0);
#pragma unroll
        for (int p = 0; p < 4; ++p) { u32x4 w; w.x = pk2(S[2 * p][0], S[2 * p][1]); w.y = pk2(S[2 * p][2], S[2 * p][3]); w.z = pk2(S[2 * p + 1][0], S[2 * p + 1][1]); w.w = pk2(S[2 * p + 1][2], S[2 * p + 1][3]);
            o = __builtin_amdgcn_mfma_f32_16x16x32_bf16(Qf[p], __builtin_bit_cast(bf16x8, w), o, 0, 0, 0); }
#pragma unroll
        for (int kt = 0; kt < 8; ++kt) { const f32x4 eb = *(const LAS f32x4*)(base + HG_EB + (ch * 128 + 16 * kt + 4 * g) * 4);
            const bf16x4 Kt = __builtin_bit_cast(bf16x4, *(const LAS u32x2*)(base + HG_KT + (ch * 128 + 16 * kt + l15) * 32 + 8 * g));
            S[kt] = __builtin_amdgcn_mfma_f32_16x16x16bf16_1k(Kt, Vf, S[kt] * eb, 0, 0, 0); }
        float* op = oA + (size_t)(b * SEQ + 64 * r + 16 * ch + 4 * g) * 512 + h * 128 + 16 * wid + l15;
#pragma unroll
        for (int j = 0; j < 4; ++j) op[(size_t)j * 512] = o[j];
    }
}
__device__ __forceinline__ void hgrn_block(LAS unsigned char* lds, const bf16_t* proj, const float* lb, float* oA, int b, int h, int tid, int wid, int lane) {
    const float lbk = lb[h * 128 + (tid & 127)];
    f32x4 S[8];
#pragma unroll
    for (int i = 0; i < 8; ++i) S[i] = (f32x4){0.f, 0.f, 0.f, 0.f};
    hgrn_stage(lds, proj, b, h, 0, lbk, tid);
    __syncthreads();
#pragma unroll 1
    for (int r = 0; r < 32; ++r) {
        if (r + 1 < 32) hgrn_stage(lds + ((r + 1) & 1) * HG_BUF, proj, b, h, r + 1, lbk, tid);
        hgrn_compute(lds + (r & 1) * HG_BUF, S, oA, b, h, r, wid, lane);
        __syncthreads();
    }
}
__global__ void __launch_bounds__(NTHR, 2) fwd_megakernel(Ptrs P) {
    extern __shared__ __attribute__((aligned(16))) unsigned char lds_raw[];
    cg::grid_group grid = cg::this_grid();
    LAS unsigned char* lds = (LAS unsigned char*)lds_raw;
    int tid_ = threadIdx.x; asm volatile("" : "+v"(tid_));
    int tid = tid_, lane = tid & 63, wid = __builtin_amdgcn_readfirstlane(tid >> 6);
#define RETID() do { tid_ = threadIdx.x; asm volatile("" : "+v"(tid_)); tid = tid_; lane = tid & 63; wid = __builtin_amdgcn_readfirstlane(tid >> 6); } while (0)
    const int G = gridDim.x, bx = blockIdx.x;
    const int NGW = G * NWAVES;
#define gw (bx * NWAVES + wid)
    unsigned char* ws = P.ws;
    float* rope = (float*)(ws + WS_ROPE); float* lbs = (float*)(ws + WS_LBS);
    bf16_t* Win_t = (bf16_t*)(ws + WS_WIN); bf16_t* Wout_t = (bf16_t*)(ws + WS_WOUT); bf16_t* Wgu_t = (bf16_t*)(ws + WS_WGU); bf16_t* Wdn_t = (bf16_t*)(ws + WS_WDN);
    bf16_t* xb = (bf16_t*)(ws + WS_XB); float* xres = (float*)(ws + WS_XRES);
    bf16_t* proj = (bf16_t*)(ws + WS_PROJ); bf16_t* mixed = (bf16_t*)(ws + WS_MIXED); bf16_t* oBp = (bf16_t*)(ws + WS_OBP); float* oA = (float*)(ws + WS_OA); float* lseB = (float*)(ws + WS_LSE);
    bf16_t* gu = (bf16_t*)(ws + WS_GU);
    float* Z = P.out;

    convert_weights(P, 0, lds, gw, NGW, wid, lane);
    {
        const float* x = P.in[0];
        for (size_t i = (size_t)bx * NTHR + tid; i < (size_t)M_TOK * DM / 8; i += (size_t)G * NTHR) {
            const f32x4 a = *(const f32x4*)(x + i * 8), c = *(const f32x4*)(x + i * 8 + 4);
            u32x4 w; w.x = pk2(a[0], a[1]); w.y = pk2(a[2], a[3]); w.z = pk2(c[0], c[1]); w.w = pk2(c[2], c[3]);
            *(u32x4*)(xb + i * 8) = w; }
        const double CF[16] = {0.15915494309189535, 0.0700865215877985, 0.03086376340470123, 0.013591370636193905, 0.005985185712713705, 0.002635675898667414, 0.001160663641240061, 0.0005111175045375439,
                               0.00022507907903927653, 9.911730936901935e-05, 4.364795279280289e-05, 1.9221100684944863e-05, 8.464330808241401e-06, 3.727408601915352e-06, 1.6414262627950345e-06, 7.228293068832865e-07};
        for (int i = bx * NTHR + tid; i < SEQ * 16; i += G * NTHR) { const int pos = i >> 4, fi = i & 15;
            double cf = CF[0];
#pragma unroll
            for (int q = 1; q < 16; ++q) cf = (fi == q) ? CF[q] : cf;
            double rev = (double)pos * cf; rev -= __builtin_floor(rev); const float rv = (float)rev;
            rope[pos * 32 + fi] = __builtin_amdgcn_cosf(rv); rope[pos * 32 + 16 + fi] = __builtin_amdgcn_sinf(rv); }
        if (bx == 0) { const float* lg = P.in[2]; const float l0 = lg[tid], l1 = lg[512 + tid]; lbs[tid] = 0.f; lbs[512 + tid] = 1.f / (1.f + __expf(l0 - l1)); }
    }
    grid.sync();

#pragma unroll 1
    for (int l = 0; l < 2; ++l) {
        const float* resid = (l == 0) ? P.in[0] : xres;
        {
            pg8::Gemm g{xb, Win_t, M_TOK, INW, DM, DM}; pg8::StaticOrder S; S.init(M_TOK, INW, G, bx);
            pg8::EpiProj E{proj, INW, rope};
            pg8::gemm_phase<pg8::EpiProj, pg8::StaticOrder, true, true>(lds, g, S, E);
        }
        grid.sync();
        RETID();
        {
            const int NH = (G > 32) ? 16 : 0;
            if (bx < NH || NH == 0) {
                for (int it = bx; it < 16; it += (NH ? NH : G)) hgrn_block(lds, proj, lbs + l * 512, oA, it >> 2, it & 3, tid, wid, lane);
            }
            if (bx >= NH) {
                const float* sinks = P.in[4] + l * 6;
                for (int it = bx - NH; it < 1536; it += G - NH) {
                    const int type = it / 384, j = it % 384;
                    int b = j / 96, h = (j % 96) / 16, rr = j % 16;
                    if (type == 0) {
                        attn_item(lds, proj, b, 4352 + h * 128, 5120 + (h / 3) * 128, 5376 + (h / 3) * 128, 1, 0, rr, 127, true, sinks[h], mixed, DM, 1280 + h * 128, nullptr, tid, wid, lane);
                    } else {
                        const int p = type - 1; int dil, res, nb;
                        if (p == 0) { dil = 1; res = 0; nb = rr; } else if (p == 1) { dil = 4; res = rr >> 2; nb = rr & 3; } else { dil = 16; res = rr; nb = 0; }
                        attn_item(lds, proj, b, 2048 + h * 128, 2816 + h * 128, 3584 + h * 128, dil, res, nb, 128, false, 0.f, oBp + (size_t)p * M_TOK * 768, 768, h * 128, lseB + (size_t)p * M_TOK * 6 + h, tid, wid, lane);
                    }
                }
            }
        }
        grid.sync();
        RETID();
        {
            const float* nw = P.in[3] + l * 128;
            for (int row = gw; row < M_TOK; row += NGW) {
                { const float* op = oA + (size_t)row * 512 + 8 * lane; const f32x4 a = *(const f32x4*)op, c = *(const f32x4*)(op + 4);
                  float ss = (a[0] * a[0] + a[1] * a[1]) + (a[2] * a[2] + a[3] * a[3]) + (c[0] * c[0] + c[1] * c[1]) + (c[2] * c[2] + c[3] * c[3]);
                  ss += __shfl_xor(ss, 1); ss += __shfl_xor(ss, 2); ss += __shfl_xor(ss, 4); ss += __shfl_xor(ss, 8);
                  const float rstd = 1.f / sqrtf(ss * (1.f / 128.f) + LN_EPS);
                  const u32x4 gv = *(const u32x4*)(proj + (size_t)row * INW + 1536 + 8 * lane);
                  const f32x4 n0 = *(const f32x4*)(nw + (8 * lane & 127)), n1 = *(const f32x4*)(nw + (8 * lane & 127) + 4);
                  float o[8];
#pragma unroll
                  for (int i = 0; i < 8; ++i) { const float gg = __uint_as_float((i & 1) ? (gv[i >> 1] & 0xffff0000u) : (gv[i >> 1] << 16)); const float ov = (i < 4 ? a[i] : c[i - 4]), nn = (i < 4 ? n0[i] : n1[i - 4]);
                      o[i] = ov * rstd * nn * (gg / (1.f + __expf(-gg))); }
                  u32x4 w; w.x = pk2(o[0], o[1]); w.y = pk2(o[2], o[3]); w.z = pk2(o[4], o[5]); w.w = pk2(o[6], o[7]);
                  *(u32x4*)(mixed + (size_t)row * DM + 8 * lane) = w; }
#pragma unroll
                for (int rep = 0; rep < 2; ++rep) { const int chn = lane + 64 * rep;
                    if (chn < 96) { const int h = chn >> 4;
                        const float l0 = lseB[(size_t)row * 6 + h], l1 = lseB[((size_t)M_TOK + row) * 6 + h], l2 = lseB[((size_t)2 * M_TOK + row) * 6 + h];
                        const float mm = fmaxf(l0, fmaxf(l1, l2)); float w0 = __expf(l0 - mm), w1 = __expf(l1 - mm), w2 = __expf(l2 - mm); const float iw = 1.f / (w0 + w1 + w2); w0 *= iw; w1 *= iw; w2 *= iw;
                        const u32x4 a = *(const u32x4*)(oBp + (size_t)row * 768 + 8 * chn), c = *(const u32x4*)(oBp + ((size_t)M_TOK + row) * 768 + 8 * chn), d = *(const u32x4*)(oBp + ((size_t)2 * M_TOK + row) * 768 + 8 * chn);
                        u32x4 w;
#pragma unroll
                        for (int q = 0; q < 4; ++q) { const float lo = w0 * __uint_as_float(a[q] << 16) + w1 * __uint_as_float(c[q] << 16) + w2 * __uint_as_float(d[q] << 16);
                            const float hi = w0 * __uint_as_float(a[q] & 0xffff0000u) + w1 * __uint_as_float(c[q] & 0xffff0000u) + w2 * __uint_as_float(d[q] & 0xffff0000u); w[q] = pk2(lo, hi); }
                        *(u32x4*)(mixed + (size_t)row * DM + 512 + 8 * chn) = w; } }
            }
        }
        grid.sync();
        {
            pg8::Gemm g{mixed, Wout_t, M_TOK, DM, DM, DM}; pg8::StaticOrder S; S.init(M_TOK, DM, G, bx);
            pg8::EpiZ E{resid, Z, ALPHA};
            pg8::gemm_phase<pg8::EpiZ, pg8::StaticOrder, true, true>(lds, g, S, E);
        }
        grid.sync();
        RETID();
        for (int row = gw; row < M_TOK; row += NGW) ln_row(Z + (size_t)row * DM, P.in[6] + l * DM, P.in[7] + l * DM, xres + (size_t)row * DM, xb + (size_t)row * DM, lane);
        grid.sync();
        {
            pg8::Gemm g{xb, Wgu_t, M_TOK, GUW, DM, DM}; pg8::StaticOrder S; S.init(M_TOK, GUW, G, bx);
            pg8::EpiStore E{gu, GUW};
            pg8::gemm_phase<pg8::EpiStore, pg8::StaticOrder, true, true>(lds, g, S, E);
        }
        grid.sync();
        RETID();
        {
            const float* cw = P.in[10] + (size_t)l * 3 * FF; const float* cb = P.in[11] + (size_t)l * FF;
            for (int it = gw; it < 256 * 11; it += NGW) { const int rb = it / 11, cgp = it % 11, c0 = 512 * cgp + 8 * lane, m0 = 32 * rb;
                float w0[8], w1[8], w2[8], bb[8], g2[8], g1[8];
#pragma unroll
                for (int i = 0; i < 8; ++i) { w0[i] = cw[c0 + i]; w1[i] = cw[FF + c0 + i]; w2[i] = cw[2 * FF + c0 + i]; bb[i] = cb[c0 + i]; g2[i] = 0.f; g1[i] = 0.f; }
                if ((m0 & (SEQ - 1)) != 0) { const u32x4 a = *(const u32x4*)(gu + (size_t)(m0 - 2) * GUW + c0), c = *(const u32x4*)(gu + (size_t)(m0 - 1) * GUW + c0);
#pragma unroll
                    for (int q = 0; q < 4; ++q) { g2[2 * q] = __uint_as_float(a[q] << 16); g2[2 * q + 1] = __uint_as_float(a[q] & 0xffff0000u); g1[2 * q] = __uint_as_float(c[q] << 16); g1[2 * q + 1] = __uint_as_float(c[q] & 0xffff0000u); } }
#pragma unroll 4
                for (int i = 0; i < 32; ++i) { bf16_t* rp = gu + (size_t)(m0 + i) * GUW + c0; const u32x4 a = *(const u32x4*)rp, uu = *(const u32x4*)(rp + FF);
                    float g0[8], hh[8];
#pragma unroll
                    for (int q = 0; q < 4; ++q) { g0[2 * q] = __uint_as_float(a[q] << 16); g0[2 * q + 1] = __uint_as_float(a[q] & 0xffff0000u); }
#pragma unroll
                    for (int q = 0; q < 8; ++q) { const float gc = bb[q] + w0[q] * g2[q] + w1[q] * g1[q] + w2[q] * g0[q]; const float uv = __uint_as_float((q & 1) ? (uu[q >> 1] & 0xffff0000u) : (uu[q >> 1] << 16));
                        hh[q] = gc / (1.f + __expf(-gc)) * uv; g2[q] = g1[q]; g1[q] = g0[q]; }
                    u32x4 w; w.x = pk2(hh[0], hh[1]); w.y = pk2(hh[2], hh[3]); w.z = pk2(hh[4], hh[5]); w.w = pk2(hh[6], hh[7]);
                    *(u32x4*)(rp + FF) = w; }
            }
        }
        grid.sync();
        {
            pg8::Gemm g{gu + FF, Wdn_t, M_TOK, DM, FF, GUW}; pg8::StaticOrder S; S.init(M_TOK, DM, G, bx);
            pg8::EpiZ E{xres, Z, ALPHA};
            pg8::gemm_phase<pg8::EpiZ, pg8::StaticOrder, true, true>(lds, g, S, E);
        }
        grid.sync();
        RETID();
        if (l == 0) {
            for (int row = gw; row < M_TOK; row += NGW) ln_row(Z + (size_t)row * DM, P.in[13], P.in[14], xres + (size_t)row * DM, xb + (size_t)row * DM, lane);
            convert_weights(P, 1, lds, gw, NGW, wid, lane);
            grid.sync();
        } else {
            for (int row = gw; row < M_TOK; row += NGW) ln_row(Z + (size_t)row * DM, P.in[13] + DM, P.in[14] + DM, Z + (size_t)row * DM, nullptr, lane);
        }
    }
}

extern "C" void kernel_launch(void* const* d_in, const int* in_sizes, int n_in, void* d_out, int out_size, void* d_ws, size_t ws_size, hipStream_t stream) {
    static int grid_blocks = 0;
    if (grid_blocks == 0) {
        if (n_in != 15 || ws_size < WS_END) { fprintf(stderr, "kernel_launch: unexpected n_in %d / ws_size %zu\n", n_in, ws_size); grid_blocks = -1; return; }
        int dev = 0, cus = 0, per_cu = 0;
        hipGetDevice(&dev); hipDeviceGetAttribute(&cus, hipDeviceAttributeMultiprocessorCount, dev);
        hipFuncSetAttribute((const void*)fwd_megakernel, hipFuncAttributeMaxDynamicSharedMemorySize, LDS_BYTES);
        hipOccupancyMaxActiveBlocksPerMultiprocessor(&per_cu, (const void*)fwd_megakernel, NTHR, LDS_BYTES);
        if (per_cu < 1) { fprintf(stderr, "kernel_launch: occupancy query says %d blocks/CU\n", per_cu); per_cu = 1; }
        grid_blocks = cus;
        (void)hipGetLastError();
    }
    if (grid_blocks < 0) return;
    Ptrs p{};
    for (int i = 0; i < 15; ++i) p.in[i] = (const float*)d_in[i];
    p.out = (float*)d_out; p.ws = (unsigned char*)d_ws;
    void* args[] = {&p};
    hipError_t e = hipLaunchCooperativeKernel((const void*)fwd_megakernel, dim3(grid_blocks), dim3(NTHR), args, LDS_BYTES, stream);
    if (e != hipSuccess) fprintf(stderr, "cooperative launch failed: %s (grid %d)\n", hipGetErrorString(e), grid_blocks);
}
```

```cpp
#include <hip/hip_runtime.h>
#include <hip/hip_cooperative_groups.h>
#include <cstdio>
#include <cstdint>
namespace cg = cooperative_groups;
namespace pg8 {
#define PG8_LAS __attribute__((address_space(3)))
typedef unsigned short bf16_t;
typedef short bf16x8 __attribute__((ext_vector_type(8)));
typedef float f32x4 __attribute__((ext_vector_type(4)));
typedef unsigned u32x4 __attribute__((ext_vector_type(4)));
constexpr int BM = 256, BK = 64, HALF = 128, HTB = HALF * BK * 2  , STAGE_BYTES = 8 * HTB, NXCD = 8, WGM = 8;

__host__ __device__ __forceinline__ int lds_byte(int r, int c) { const int st = (r >> 4) * 2 + (c >> 5), rr = r & 15, cc = c & 31, ob = rr * 64 + cc * 2; return st * 1024 + (ob ^ (((ob >> 9) & 1) << 5)); }
__host__ __device__ __forceinline__ void stage_rc(int b, int& R, int& C) { const int st = b / 1024, sb = b % 1024, swz = sb ^ (((sb >> 9) & 1) << 5); R = (st >> 1) * 16 + swz / 64; C = (st & 1) * 32 + (swz % 64) / 2; }
__host__ __device__ __forceinline__ int perm32(int rho) { const int n = rho >> 4, i = rho & 15; return 8 * (i >> 2) + 4 * n + (i & 3); }

struct Unit { int pm, pn; };

struct StaticOrder {
    int nM, nN, nwg, G, c;
    __host__ __device__ void init(int M, int N, int G_, int c_) { nM = M / BM; nN = N / BM; nwg = nM * nN; G = G_; c = c_; }
    __host__ __device__ bool next(int i, Unit& u) const {
        const long L = (long)i * G + c; if (L >= nwg) return false;
        int wgid = (int)L; { const int q = nwg / NXCD, r = nwg % NXCD, xcd = wgid % NXCD, off = wgid / NXCD; wgid = (xcd < r ? xcd * (q + 1) : r * (q + 1) + (xcd - r) * q) + off; }
        const int nig = WGM * nN, gid = wgid / nig, fm = gid * WGM, gsz = (nM - fm) < WGM ? (nM - fm) : WGM;
        u.pm = fm + ((wgid % nig) % gsz); u.pn = (wgid % nig) / gsz; return true;
    }
    __device__ __forceinline__ void a_ready(const Unit&) const {}
    __device__ __forceinline__ void done(const Unit&) const {}
};

struct Gemm { const bf16_t* A; const bf16_t* Bt; int M, N, K, lda; };
__device__ __forceinline__ unsigned cvt_pk_bf16(float lo, float hi) { unsigned r; asm volatile("v_cvt_pk_bf16_f32 %0, %1, %2" : "=v"(r) : "v"(lo), "v"(hi)); return r; }

struct EpiStore {
    static constexpr bool PERM = true, AFTER_DRAIN = false;
    bf16_t* O; int ldc;
    __device__ __forceinline__ void operator()(const f32x4 (&acc)[2][2][4][2], const Unit& u, int wr, int wc, int fr, int fq) const {
        const int row0 = u.pm * BM + wr * 64 + fr; const int col0 = u.pn * BM + wc * 32 + 8 * fq;
#pragma unroll
        for (int ai = 0; ai < 2; ++ai)
#pragma unroll
            for (int m = 0; m < 4; ++m) { bf16_t* rowp = O + (size_t)(row0 + ai * HALF + m * 16) * ldc + col0;
#pragma unroll
                for (int bj = 0; bj < 2; ++bj) { const f32x4 v0 = acc[ai][bj][m][0], v1 = acc[ai][bj][m][1];
                    u32x4 w; w.x = cvt_pk_bf16(v0[0], v0[1]); w.y = cvt_pk_bf16(v0[2], v0[3]); w.z = cvt_pk_bf16(v1[0], v1[1]); w.w = cvt_pk_bf16(v1[2], v1[3]);
                    *(u32x4*)(rowp + bj * HALF) = w; } }
    }
};
template <int CTRL> __device__ __forceinline__ float row_shr_fill1(float v) { return __int_as_float(__builtin_amdgcn_update_dpp(0x3f800000, __float_as_int(v), CTRL, 0xf, 0xf, false)); }
struct EpiProj {
    static constexpr bool PERM = true, AFTER_DRAIN = false;
    bf16_t* O; int ldc; const float* rope;
    bf16_t* QTg; bf16_t* KHg; bf16_t* KTg; float* EBg; const float* lb;
    __device__ __forceinline__ void hgrn(const f32x4 (&acc)[2][2][4][2], const Unit& u, int wr, int wc, int fr, int fq) const {
        const int h = u.pn, kb = h * 128 + wc * 32 + 8 * fq, lane = fq * 16 + fr;
        const f32x4 lb0 = *(const f32x4*)(lb + kb), lb1 = *(const f32x4*)(lb + kb + 4);
#pragma unroll
        for (int ai = 0; ai < 2; ++ai)
#pragma unroll
            for (int m = 0; m < 4; ++m) { const int row = u.pm * BM + ai * HALF + wr * 64 + m * 16 + fr, chunk = row >> 4;
                float qt[8], kh[8], kt[8], el[8];
#pragma unroll
                for (int n = 0; n < 2; ++n)
#pragma unroll
                    for (int i = 0; i < 4; ++i) { const int ix = 4 * n + i; const float q = acc[ai][0][m][n][i]; float fl = acc[ai][1][m][n][i]; const float lbk = n ? lb1[i] : lb0[i];
                        fl = fminf(fmaxf(fl, -30.f), 30.f);
                        const float e = __expf(-fl), sg = __builtin_amdgcn_rcpf(1.f + e), oml = 1.f - lbk, f = lbk + oml * sg, kk = oml * e * sg;
                        float E = f;
                        E *= row_shr_fill1<0x111>(E); E *= row_shr_fill1<0x112>(E); E *= row_shr_fill1<0x114>(E); E *= row_shr_fill1<0x118>(E);
                        const float El = __shfl(E, (lane & 48) | 15);
                        const float qh = q * __builtin_amdgcn_rcpf(1.f + __expf(-q));
                        const float iE = __builtin_amdgcn_rcpf(E);
                        qt[ix] = qh * E; kh[ix] = kk * iE; kt[ix] = kh[ix] * El; el[ix] = El; }
                u32x4 w; w.x = cvt_pk_bf16(qt[0], qt[1]); w.y = cvt_pk_bf16(qt[2], qt[3]); w.z = cvt_pk_bf16(qt[4], qt[5]); w.w = cvt_pk_bf16(qt[6], qt[7]);
                *(u32x4*)(QTg + (size_t)row * 512 + kb) = w;
                w.x = cvt_pk_bf16(kh[0], kh[1]); w.y = cvt_pk_bf16(kh[2], kh[3]); w.z = cvt_pk_bf16(kh[4], kh[5]); w.w = cvt_pk_bf16(kh[6], kh[7]);
                *(u32x4*)(KHg + (size_t)row * 512 + kb) = w;
                bf16_t* ktp = KTg + ((size_t)chunk * 512 + kb) * 16 + fr;
#pragma unroll
                for (int ix = 0; ix < 8; ix += 2) { const unsigned pr = cvt_pk_bf16(kt[ix], kt[ix + 1]); ktp[ix * 16] = (bf16_t)(pr & 0xffffu); ktp[(ix + 1) * 16] = (bf16_t)(pr >> 16); }
                if (fr == 0) { float* ep = EBg + (size_t)chunk * 512 + kb; *(f32x4*)ep = (f32x4){el[0], el[1], el[2], el[3]}; *(f32x4*)(ep + 4) = (f32x4){el[4], el[5], el[6], el[7]}; }
            }
    }
    __device__ __forceinline__ void operator()(const f32x4 (&acc)[2][2][4][2], const Unit& u, int wr, int wc, int fr, int fq) const {
        if (u.pn < 4) { hgrn(acc, u, wr, wc, fr, fq); return; }
        const int row0 = u.pm * BM + wr * 64 + fr; const int col0 = u.pn * BM + wc * 32 + 8 * fq;
        bool rp[2];
#pragma unroll
        for (int bj = 0; bj < 2; ++bj) { const int cb = u.pn * BM + bj * HALF; rp[bj] = (wc == 0) && ((cb >= 2048 && cb < 3584) || (cb >= 4352 && cb < 5376)); }
        const bool anyr = rp[0] || rp[1];
        const float sgn = (fq < 2) ? -1.f : 1.f;
#pragma unroll
        for (int ai = 0; ai < 2; ++ai)
#pragma unroll
            for (int m = 0; m < 4; ++m) { const int row = row0 + ai * HALF + m * 16; bf16_t* rowp = O + (size_t)row * ldc + col0;
                f32x4 c0 = {1.f, 1.f, 1.f, 1.f}, c1 = c0, s0 = {0.f, 0.f, 0.f, 0.f}, s1 = s0;
                if (anyr) { const float* rt = rope + (size_t)(row & 2047) * 32 + 8 * (fq & 1);
                    c0 = *(const f32x4*)(rt); c1 = *(const f32x4*)(rt + 4); s0 = *(const f32x4*)(rt + 16); s1 = *(const f32x4*)(rt + 20); }
#pragma unroll
                for (int bj = 0; bj < 2; ++bj) { f32x4 v0 = acc[ai][bj][m][0], v1 = acc[ai][bj][m][1];
                    if (rp[bj]) {
                        f32x4 p0, p1;
#pragma unroll
                        for (int i = 0; i < 4; ++i) { p0[i] = __shfl_xor(v0[i], 32); p1[i] = __shfl_xor(v1[i], 32); }
                        v0 = v0 * c0 + (p0 * s0) * sgn; v1 = v1 * c1 + (p1 * s1) * sgn;
                    }
                    u32x4 w; w.x = cvt_pk_bf16(v0[0], v0[1]); w.y = cvt_pk_bf16(v0[2], v0[3]); w.z = cvt_pk_bf16(v1[0], v1[1]); w.w = cvt_pk_bf16(v1[2], v1[3]);
                    *(u32x4*)(rowp + bj * HALF) = w; } }
    }
};
struct EpiZ {
    static constexpr bool PERM = false, AFTER_DRAIN = false;
    const float* res; float* Z; float alpha;
    __device__ __forceinline__ void operator()(const f32x4 (&acc)[2][2][4][2], const Unit& u, int wr, int wc, int fr, int fq) const {
        const int col0 = u.pn * BM + wc * 32 + 4 * fq;
#pragma unroll
        for (int ai = 0; ai < 2; ++ai)
#pragma unroll
            for (int m = 0; m < 4; ++m) { const int r = u.pm * BM + ai * HALF + wr * 64 + m * 16 + fr; const size_t off = (size_t)r * 2048 + col0;
#pragma unroll
                for (int bj = 0; bj < 2; ++bj)
#pragma unroll
                    for (int n = 0; n < 2; ++n) { const f32x4 bs = *(const f32x4*)(res + off + bj * HALF + n * 16); const f32x4 o = bs * alpha + acc[ai][bj][m][n]; *(f32x4*)(Z + off + bj * HALF + n * 16) = o; } }
    }
};
template <class Epi, class Sched, bool ALIGN_EPI = false, bool SP2 = false>
__device__ __forceinline__ void gemm_phase(PG8_LAS unsigned char* lds, const Gemm g, const Sched& S, const Epi& E) {
    int tid_ = threadIdx.x; asm volatile("" : "+v"(tid_));
    const int tid = tid_, wid = __builtin_amdgcn_readfirstlane(tid >> 6), lane = tid & 63, wr = wid >> 2, wc = wid & 3, fr = lane & 15, fq = lane >> 4;
    const int K = g.K, nt = K / BK, lda = g.lda;
    unsigned voffA[2], voffB[2];
#pragma unroll
    for (int i = 0; i < 2; ++i) { int R, C; stage_rc(tid * 16 + i * 8192, R, C); const int Rb = Epi::PERM ? ((R & ~31) + perm32(R & 31)) : R;
        voffA[i] = (unsigned)(R * lda + C) * 2u; voffB[i] = (unsigned)(Rb * K + C) * 2u; }
    const size_t kstep = (size_t)(BK * 2);
    const size_t hstep = (size_t)HALF * K * 2;
    const size_t tstep = 2 * hstep; const size_t hstepA = (size_t)HALF * lda * 2, tstepA = 2 * hstepA;
    const unsigned ldsw = (unsigned)wid * 1024u;
    const int aoff = lds_byte(wr * 64 + fr, fq * 8), boff = lds_byte(wc * 32 + fr, fq * 8);
#define PG8_SA(b, h) (((b) * 2 + (h)) * HTB)
#define PG8_SB(b, h) ((4 + (b) * 2 + (h)) * HTB)
#define PG8_STAGE(bufoff, gbase, voff) do { _Pragma("unroll") for (int _i = 0; _i < 2; ++_i) \
        __builtin_amdgcn_global_load_lds((const unsigned*)((const char*)(gbase) + (voff)[_i]), (PG8_LAS unsigned*)(lds + (bufoff) + ldsw + _i * 8192), 16, 0, 0); } while (0)
#define PG8_LDA(dst, b, h) do { _Pragma("unroll") for (int m = 0; m < 4; ++m) _Pragma("unroll") for (int k = 0; k < 2; ++k) dst[m][k] = *(const PG8_LAS bf16x8*)(lds + PG8_SA(b, h) + aoff + m * 2048 + k * 1024); } while (0)
#define PG8_LDB(dst, b, h) do { _Pragma("unroll") for (int n = 0; n < 2; ++n) _Pragma("unroll") for (int k = 0; k < 2; ++k) dst[n][k] = *(const PG8_LAS bf16x8*)(lds + PG8_SB(b, h) + boff + n * 2048 + k * 1024); } while (0)
#define PG8_MMA(ai, bj, At, Bt) do { __builtin_amdgcn_s_setprio(1); _Pragma("unroll") for (int m = 0; m < 4; ++m) _Pragma("unroll") for (int n = 0; n < 2; ++n) _Pragma("unroll") for (int k = 0; k < 2; ++k) \
        acc[ai][bj][m][n] = __builtin_amdgcn_mfma_f32_16x16x32_bf16(Bt[n][k], At[m][k], acc[ai][bj][m][n], 0, 0, 0); __builtin_amdgcn_s_setprio(0); } while (0)
#define PG8_WAIT_V(n) asm volatile("s_waitcnt vmcnt(" #n ")" ::: "memory")
#define PG8_WAIT_L(n) asm volatile("s_waitcnt lgkmcnt(" #n ")" ::: "memory")
#define PG8_BAR __builtin_amdgcn_s_barrier()
#define PG8_SCHED __builtin_amdgcn_sched_barrier(0)
    Unit cur, nxt; int ui = 0;
    if (!S.next(0, cur)) return;
    f32x4 acc[2][2][4][2];
#pragma unroll
    for (int a = 0; a < 2; ++a)
#pragma unroll
        for (int b = 0; b < 2; ++b)
#pragma unroll
            for (int m = 0; m < 4; ++m)
#pragma unroll
                for (int n = 0; n < 2; ++n) acc[a][b][m][n] = (f32x4){0.f, 0.f, 0.f, 0.f};
    bf16x8 At[4][2], B0[2][2], B1[2][2];
    const char* cA = (const char*)g.A + (size_t)cur.pm * tstepA; const char* cB = (const char*)g.Bt + (size_t)cur.pn * tstep;
    S.a_ready(cur);
    if constexpr (SP2) {
        PG8_STAGE(PG8_SB(0, 0), cB, voffB); PG8_STAGE(PG8_SB(0, 1), cB + hstep, voffB); PG8_STAGE(PG8_SA(0, 0), cA, voffA); PG8_STAGE(PG8_SA(0, 1), cA + hstepA, voffA);
        if (wr == 1) PG8_BAR;
        PG8_WAIT_V(2); PG8_BAR;
        PG8_STAGE(PG8_SB(1, 0), cB + kstep, voffB); PG8_STAGE(PG8_SA(1, 0), cA + kstep, voffA); PG8_STAGE(PG8_SB(1, 1), cB + hstep + kstep, voffB);
        PG8_WAIT_V(6); PG8_BAR;
    } else {
        PG8_STAGE(PG8_SB(0, 0), cB, voffB); PG8_STAGE(PG8_SA(0, 0), cA, voffA); PG8_STAGE(PG8_SB(0, 1), cB + hstep, voffB); PG8_STAGE(PG8_SA(0, 1), cA + hstepA, voffA);
        if (wr == 1) PG8_BAR;
        PG8_WAIT_V(4); PG8_BAR;
        PG8_STAGE(PG8_SB(1, 0), cB + kstep, voffB); PG8_STAGE(PG8_SA(1, 0), cA + kstep, voffA); PG8_STAGE(PG8_SB(1, 1), cB + hstep + kstep, voffB);
        PG8_WAIT_V(6); PG8_BAR;
    }
    for (;;) {
        const bool has_next = S.next(ui + 1, nxt);
        const char* nA = has_next ? (const char*)g.A + (size_t)nxt.pm * tstepA : cA; const char* nB = has_next ? (const char*)g.Bt + (size_t)nxt.pn * tstep : cB;
        for (int t = 0; t < nt; t += 2) {
            const bool last = (t == nt - 2);
            const char* a1 = cA + (size_t)(t + 1) * kstep;
            const char* a2 = last ? nA : cA + (size_t)(t + 2) * kstep; const char* b2 = last ? nB : cB + (size_t)(t + 2) * kstep;
            const char* a3 = a2 + kstep; const char* b3 = b2 + kstep;
            if (last && has_next) S.a_ready(nxt);
            if constexpr (SP2) {
            PG8_LDB(B0, 0, 0); PG8_LDB(B1, 0, 1); PG8_SCHED; PG8_LDA(At, 0, 0); PG8_STAGE(PG8_SA(1, 1), a1 + hstepA, voffA);
            PG8_WAIT_V(8); PG8_WAIT_L(0); PG8_BAR; PG8_MMA(0, 0, At, B0); PG8_MMA(0, 1, At, B1); PG8_BAR; PG8_SCHED;
            PG8_LDA(At, 0, 1); PG8_STAGE(PG8_SB(0, 0), b2, voffB); PG8_STAGE(PG8_SB(0, 1), b2 + hstep, voffB); PG8_STAGE(PG8_SA(0, 0), a2, voffA);
            PG8_WAIT_V(8); PG8_WAIT_L(0); PG8_BAR; PG8_MMA(1, 0, At, B0); PG8_MMA(1, 1, At, B1); PG8_BAR; PG8_SCHED;
            PG8_LDB(B0, 1, 0); PG8_LDB(B1, 1, 1); PG8_SCHED; PG8_LDA(At, 1, 0); PG8_STAGE(PG8_SA(0, 1), a2 + hstepA, voffA);
            PG8_WAIT_V(8); PG8_WAIT_L(0); PG8_BAR; PG8_MMA(0, 0, At, B0); PG8_MMA(0, 1, At, B1); PG8_BAR; PG8_SCHED;
            PG8_LDA(At, 1, 1); PG8_STAGE(PG8_SB(1, 0), b3, voffB); PG8_STAGE(PG8_SB(1, 1), b3 + hstep, voffB); PG8_STAGE(PG8_SA(1, 0), a3, voffA);
            PG8_WAIT_V(8); PG8_WAIT_L(0); PG8_BAR; PG8_MMA(1, 0, At, B0); PG8_MMA(1, 1, At, B1); PG8_BAR; PG8_SCHED;
            } else {
            PG8_LDB(B0, 0, 0); PG8_SCHED; PG8_LDA(At, 0, 0); PG8_STAGE(PG8_SA(1, 1), a1 + hstepA, voffA);
            PG8_WAIT_L(8); PG8_BAR; PG8_WAIT_L(0); PG8_MMA(0, 0, At, B0); PG8_BAR; PG8_SCHED;
            PG8_LDB(B1, 0, 1); PG8_STAGE(PG8_SB(0, 0), b2, voffB);
            PG8_BAR; PG8_WAIT_L(0); PG8_MMA(0, 1, At, B1); PG8_BAR;
            PG8_LDA(At, 0, 1); PG8_STAGE(PG8_SA(0, 0), a2, voffA);
            PG8_BAR; PG8_WAIT_L(0); PG8_MMA(1, 0, At, B0); PG8_BAR; PG8_SCHED;
            PG8_STAGE(PG8_SB(0, 1), b2 + hstep, voffB);
            PG8_WAIT_V(6); PG8_BAR; PG8_MMA(1, 1, At, B1); PG8_BAR;
            PG8_LDB(B0, 1, 0); PG8_SCHED; PG8_LDA(At, 1, 0); PG8_STAGE(PG8_SA(0, 1), a2 + hstepA, voffA);
            PG8_WAIT_L(8); PG8_BAR; PG8_WAIT_L(0); PG8_MMA(0, 0, At, B0); PG8_BAR; PG8_SCHED;
            PG8_LDB(B1, 1, 1); PG8_STAGE(PG8_SB(1, 0), b3, voffB);
            PG8_BAR; PG8_WAIT_L(0); PG8_MMA(0, 1, At, B1); PG8_BAR;
            PG8_LDA(At, 1, 1); PG8_STAGE(PG8_SA(1, 0), a3, voffA);
            PG8_BAR; PG8_WAIT_L(0); PG8_MMA(1, 0, At, B0); PG8_BAR; PG8_SCHED;
            PG8_STAGE(PG8_SB(1, 1), b3 + hstep, voffB);
            PG8_WAIT_V(6); PG8_BAR; PG8_MMA(1, 1, At, B1); PG8_BAR;
            }
        }
        if constexpr (ALIGN_EPI) { if (wr == 0) PG8_BAR; }
        if constexpr (!Epi::AFTER_DRAIN) { E(acc, cur, wr, wc, fr, fq); S.done(cur); }
        if (!has_next) break;
#pragma unroll
        for (int a = 0; a < 2; ++a)
#pragma unroll
            for (int b = 0; b < 2; ++b)
#pragma unroll
                for (int m = 0; m < 4; ++m)
#pragma unroll
                    for (int n = 0; n < 2; ++n) acc[a][b][m][n] = (f32x4){0.f, 0.f, 0.f, 0.f};
        cur = nxt; cA = nA; cB = nB; ++ui;
        if constexpr (ALIGN_EPI) { if (wr == 1) PG8_BAR; }
    }
    PG8_WAIT_V(0);
    if constexpr (!ALIGN_EPI) { if (wr == 0) PG8_BAR; }
    PG8_BAR;
    if constexpr (Epi::AFTER_DRAIN) { E.fused(acc, cur, wr, wc, fr, fq, lds, wid, lane); S.done(cur); }
#undef PG8_SA
#undef PG8_SB
#undef PG8_STAGE
#undef PG8_LDA
#undef PG8_LDB
#undef PG8_MMA
#undef PG8_WAIT_V
#undef PG8_WAIT_L
#undef PG8_BAR
#undef PG8_SCHED
}
}
#define LAS __attribute__((address_space(3)))
typedef unsigned short bf16_t;
typedef short bf16x8 __attribute__((ext_vector_type(8)));
typedef short bf16x4 __attribute__((ext_vector_type(4)));
typedef float f32x4 __attribute__((ext_vector_type(4)));
typedef unsigned u32x4 __attribute__((ext_vector_type(4)));
typedef unsigned u32x2 __attribute__((ext_vector_type(2)));
constexpr int M_TOK = 8192, SEQ = 2048, DM = 2048, INW = 5632, FF = 5632, GUW = 11264;
constexpr float ALPHA = 1.4142135623730951f, LN_EPS = 1e-5f;
constexpr size_t MiB = 1u << 20;
constexpr size_t WS_ROPE = 64 * 1024, WS_LBS = 320 * 1024;
constexpr size_t WS_WIN = 1 * MiB, WS_WOUT = 23 * MiB, WS_WGU = 31 * MiB, WS_WDN = 75 * MiB;
constexpr size_t WS_XB = 97 * MiB, WS_XRES = 129 * MiB, WS_R = 193 * MiB;
constexpr size_t WS_PROJ = WS_R, WS_MIXED = WS_R + 88 * MiB, WS_OBP = WS_R + 120 * MiB, WS_OA = WS_R + 156 * MiB, WS_LSE = WS_R + 172 * MiB;
constexpr size_t WS_GU = WS_R;
constexpr size_t WS_QT = WS_R + 173 * MiB, WS_KH = WS_R + 181 * MiB, WS_KT = WS_R + 189 * MiB, WS_EB = WS_R + 197 * MiB;
constexpr size_t WS_END = 448 * MiB;
constexpr int LDS_BYTES = 141312 + 1024;
constexpr int NWAVES = 8, NTHR = 512;

__device__ __forceinline__ float bf2f(unsigned short v) { return __uint_as_float((unsigned)v << 16); }
__device__ __forceinline__ unsigned f2bf(float f) { unsigned u = __float_as_uint(f); return (u + 0x7fffu + ((u >> 16) & 1u)) >> 16; }
__device__ __forceinline__ unsigned pk2(float lo, float hi) { return pg8::cvt_pk_bf16(lo, hi); }
__device__ __forceinline__ float wave_sum(float v) {
#pragma unroll
    for (int o = 1; o < 64; o <<= 1) v += __shfl_xor(v, o);
    return v;
}
#define LDS_WAIT() asm volatile("s_waitcnt lgkmcnt(0)" ::: "memory")

__device__ __forceinline__ void transpose_item(const float* W, int K, int N, bf16_t* WT, int k0, int n0, int new_n0, int lane) {
    typedef float f32x2 __attribute__((ext_vector_type(2)));
    const float* src = W + (size_t)k0 * N + n0 + 2 * lane;
    bf16_t* d0 = WT + (size_t)(new_n0 + 2 * lane) * K + k0; bf16_t* d1 = d0 + K;
#pragma unroll
    for (int hb = 0; hb < 2; ++hb) {
        f32x2 v[32];
#pragma unroll
        for (int i = 0; i < 32; ++i) v[i] = __builtin_nontemporal_load((const f32x2*)(src + (size_t)(32 * hb + i) * N));
#pragma unroll
        for (int q = 0; q < 4; ++q) { u32x4 a, c;
            a.x = pk2(v[8 * q][0], v[8 * q + 1][0]); a.y = pk2(v[8 * q + 2][0], v[8 * q + 3][0]); a.z = pk2(v[8 * q + 4][0], v[8 * q + 5][0]); a.w = pk2(v[8 * q + 6][0], v[8 * q + 7][0]);
            c.x = pk2(v[8 * q][1], v[8 * q + 1][1]); c.y = pk2(v[8 * q + 2][1], v[8 * q + 3][1]); c.z = pk2(v[8 * q + 4][1], v[8 * q + 5][1]); c.w = pk2(v[8 * q + 6][1], v[8 * q + 7][1]);
            *(u32x4*)(d0 + 32 * hb + 8 * q) = a; *(u32x4*)(d1 + 32 * hb + 8 * q) = c; }
    }
}

struct Ptrs {
    const float* in[15]; float* out; unsigned char* ws;
};

__device__ __forceinline__ void convert_weights(const Ptrs& P, int l, int gw, int NGW, int lane) {
    constexpr int I_IN = 32 * 44, I_OUT = 32 * 16, I_G = 32 * 44, I_D = 88 * 16;
    constexpr int NITEMS = I_IN + I_OUT + 2 * I_G + I_D;
    bf16_t* Win_t = (bf16_t*)(P.ws + WS_WIN); bf16_t* Wout_t = (bf16_t*)(P.ws + WS_WOUT); bf16_t* Wgu_t = (bf16_t*)(P.ws + WS_WGU); bf16_t* Wdn_t = (bf16_t*)(P.ws + WS_WDN);
    const float* w_in = P.in[1] + (size_t)l * DM * INW; const float* w_out = P.in[5] + (size_t)l * DM * DM;
    const float* w_gate = P.in[8] + (size_t)l * DM * FF; const float* w_up = P.in[9] + (size_t)l * DM * FF; const float* w_down = P.in[12] + (size_t)l * FF * DM;
    for (int it = gw; it < NITEMS; it += NGW) {
        int r = it;
        if (r < I_IN) { const int kb = r / 44, nb = r % 44, n0 = 128 * nb; const int nn = (nb < 8) ? ((nb & 3) * 256 + (nb >> 2) * 128) : n0;
            transpose_item(w_in, DM, INW, Win_t, 64 * kb, n0, nn, lane); continue; } r -= I_IN;
        if (r < I_OUT) { transpose_item(w_out, DM, DM, Wout_t, 64 * (r / 16), 128 * (r % 16), 128 * (r % 16), lane); continue; } r -= I_OUT;
        if (r < I_G) { transpose_item(w_gate, DM, FF, Wgu_t, 64 * (r / 44), 128 * (r % 44), 128 * (r % 44), lane); continue; } r -= I_G;
        if (r < I_G) { transpose_item(w_up, DM, FF, Wgu_t, 64 * (r / 44), 128 * (r % 44), FF + 128 * (r % 44), lane); continue; } r -= I_G;
        transpose_item(w_down, FF, DM, Wdn_t, 64 * (r / 16), 128 * (r % 16), 128 * (r % 16), lane);
    }
}

__device__ __forceinline__ void ln_row(const float* zrow, const float* gam, const float* bet, float* out_f, bf16_t* out_b, int lane) {
    f32x4 v[8]; float s = 0.f;
#pragma unroll
    for (int j = 0; j < 8; ++j) { v[j] = *(const f32x4*)(zrow + 4 * lane + 256 * j); s += (v[j][0] + v[j][1]) + (v[j][2] + v[j][3]); }
    const float mean = wave_sum(s) * (1.f / 2048.f); float s2 = 0.f;
#pragma unroll
    for (int j = 0; j < 8; ++j) { v[j] = v[j] - mean; s2 += (v[j][0] * v[j][0] + v[j][1] * v[j][1]) + (v[j][2] * v[j][2] + v[j][3] * v[j][3]); }
    const float rstd = 1.f / sqrtf(wave_sum(s2) * (1.f / 2048.f) + LN_EPS);
#pragma unroll
    for (int j = 0; j < 8; ++j) { const f32x4 gg = *(const f32x4*)(gam + 4 * lane + 256 * j), bb = *(const f32x4*)(bet + 4 * lane + 256 * j);
        const f32x4 o = v[j] * rstd * gg + bb;
        if (out_f) *(f32x4*)(out_f + 4 * lane + 256 * j) = o;
        if (out_b) { u32x2 w; w.x = pk2(o[0], o[1]); w.y = pk2(o[2], o[3]); *(u32x2*)(out_b + 4 * lane + 256 * j) = w; } }
}

__device__ __forceinline__ void attn_item(LAS unsigned char* lds, const bf16_t* proj, int b, int qcol, int kcol, int vcol, int dil, int res, int nb, int maxlag,
                                          bool hasSink, float sink, bf16_t* out, int ldo, int ocol, float* lsep, int tid, int wid, int lane) {
    constexpr int KROW = 272, VROW = 528;
    LAS unsigned char* Ks = lds; LAS unsigned char* Vs = lds + 256 * KROW;
    const int tk0 = (nb - 1) * 128;
#pragma unroll
    for (int i = 0; i < 8; ++i) { const int e = tid + 512 * i, key = e >> 4, ch = e & 15, tau = tk0 + key;
        u32x4 v = {0u, 0u, 0u, 0u};
        if (tau >= 0) v = *(const u32x4*)(proj + (size_t)(b * SEQ + tau * dil + res) * INW + kcol + ch * 8);
        *(LAS u32x4*)(Ks + key * KROW + ch * 16) = v; }
#pragma unroll
    for (int i = 0; i < 4; ++i) { const int e = tid + 512 * i, ch = (e & 1) | (((e >> 6) & 7) << 1), kp = ((e >> 1) & 31) | ((e >> 9) << 5), tau0 = tk0 + 2 * kp;
        u32x4 a = {0u, 0u, 0u, 0u}, c = {0u, 0u, 0u, 0u};
        if (tau0 >= 0) { a = *(const u32x4*)(proj + (size_t)(b * SEQ + tau0 * dil + res) * INW + vcol + ch * 8); c = *(const u32x4*)(proj + (size_t)(b * SEQ + (tau0 + 1) * dil + res) * INW + vcol + ch * 8); }
#pragma unroll
        for (int q = 0; q < 4; ++q) {
            *(LAS unsigned*)(Vs + (ch * 8 + 2 * q) * VROW + kp * 4) = (a[q] & 0xffffu) | (c[q] << 16);
            *(LAS unsigned*)(Vs + (ch * 8 + 2 * q + 1) * VROW + kp * 4) = (a[q] >> 16) | (c[q] & 0xffff0000u); } }
    __syncthreads();
    const int l15 = lane & 15, g = lane >> 4;
    const int r = 16 * wid + l15, tq = (nb * 128 + r) * dil + res; const size_t qrow = (size_t)b * SEQ + tq;
    bf16x8 Qf[4];
#pragma unroll
    for (int kk = 0; kk < 4; ++kk) Qf[kk] = *(const bf16x8*)(proj + qrow * INW + qcol + 32 * kk + 8 * g);
    f32x4 S[10];
#pragma unroll
    for (int i = 0; i < 10; ++i) { const int kt = wid + i, ktc = kt < 15 ? kt : 15; f32x4 acc = {0.f, 0.f, 0.f, 0.f};
#pragma unroll
        for (int kk = 0; kk < 4; ++kk) { const bf16x8 A = *(const LAS bf16x8*)(Ks + (16 * ktc + l15) * KROW + (32 * kk + 8 * g) * 2); acc = __builtin_amdgcn_mfma_f32_16x16x32_bf16(A, Qf[kk], acc, 0, 0, 0); }
        S[i] = acc; }
    const float scale = 0.08838834764831845f;
    float mx = -1e30f;
#pragma unroll
    for (int i = 0; i < 10; ++i)
#pragma unroll
        for (int j = 0; j < 4; ++j) { const int c = 16 * (wid + i) + 4 * g + j, lag = 128 + r - c; const bool valid = (wid + i < 16) && lag >= 0 && lag <= maxlag && (tk0 + c >= 0);
            const float s = valid ? S[i][j] * scale : -1e30f; S[i][j] = s; mx = fmaxf(mx, s); }
    mx = fmaxf(mx, __shfl_xor(mx, 16)); mx = fmaxf(mx, __shfl_xor(mx, 32));
    if (hasSink) mx = fmaxf(mx, sink);
    float sum = 0.f;
#pragma unroll
    for (int i = 0; i < 10; ++i)
#pragma unroll
        for (int j = 0; j < 4; ++j) { const float p = __expf(S[i][j] - mx); S[i][j] = p; sum += p; }
    sum += __shfl_xor(sum, 16); sum += __shfl_xor(sum, 32);
    if (hasSink) sum += __expf(sink - mx);
    bf16x8 Pf[5];
#pragma unroll
    for (int sl = 0; sl < 5; ++sl) { u32x4 w; w.x = pk2(S[2 * sl][0], S[2 * sl][1]); w.y = pk2(S[2 * sl][2], S[2 * sl][3]); w.z = pk2(S[2 * sl + 1][0], S[2 * sl + 1][1]); w.w = pk2(S[2 * sl + 1][2], S[2 * sl + 1][3]); Pf[sl] = __builtin_bit_cast(bf16x8, w); }
    const float inv = 1.f / sum;
#pragma unroll
    for (int dt = 0; dt < 8; ++dt) { f32x4 acc = {0.f, 0.f, 0.f, 0.f}; const int d = 16 * dt + l15;
#pragma unroll
        for (int sl = 0; sl < 5; ++sl) { const int k0 = (wid + 2 * sl) < 15 ? (wid + 2 * sl) : 15, k1 = (wid + 2 * sl + 1) < 15 ? (wid + 2 * sl + 1) : 15;
            const u32x2 lo = *(const LAS u32x2*)(Vs + d * VROW + (16 * k0 + 4 * g) * 2), hi = *(const LAS u32x2*)(Vs + d * VROW + (16 * k1 + 4 * g) * 2);
            u32x4 w; w.x = lo.x; w.y = lo.y; w.z = hi.x; w.w = hi.y;
            acc = __builtin_amdgcn_mfma_f32_16x16x32_bf16(__builtin_bit_cast(bf16x8, w), Pf[sl], acc, 0, 0, 0); }
        acc = acc * inv; u32x2 w; w.x = pk2(acc[0], acc[1]); w.y = pk2(acc[2], acc[3]);
        *(u32x2*)(out + qrow * ldo + ocol + 16 * dt + 4 * g) = w; }
    if (lsep && g == 0) lsep[qrow * 6] = mx + __logf(sum);
    __syncthreads();
}

constexpr int HG_QT = 0, HG_KH = 17408, HG_V = 34816, HG_KT = 52224, HG_EB = 68608, HG_BUF = 70656;
struct HgRegs { u32x4 q[2], k[2], v[2], t[2], e; };
__device__ __forceinline__ void hgrn_load(HgRegs& R, const bf16_t* QTg, const bf16_t* KHg, const bf16_t* KTg, const float* EBg, const bf16_t* proj, int b, int h, int r, int tid) {
    const size_t row0 = (size_t)b * SEQ + 64 * r; const size_t c0 = row0 >> 4;
#pragma unroll
    for (int i = 0; i < 2; ++i) { const int e = tid + 512 * i, row = e >> 4, ch = e & 15;
        R.q[i] = *(const u32x4*)(QTg + (row0 + row) * 512 + h * 128 + ch * 8);
        R.k[i] = *(const u32x4*)(KHg + (row0 + row) * 512 + h * 128 + ch * 8);
        R.v[i] = *(const u32x4*)(proj + (row0 + row) * INW + 1024 + h * 128 + ch * 8);
        const int chk = e >> 8, wi = e & 255;
        R.t[i] = *(const u32x4*)(KTg + ((c0 + chk) * 512 + h * 128) * 16 + wi * 8); }
    R.e = (u32x4){0u, 0u, 0u, 0u};
    if (tid < 128) { const int chk = tid >> 5, wi = tid & 31; R.e = *(const u32x4*)(EBg + (c0 + chk) * 512 + h * 128 + wi * 4); }
}
__device__ __forceinline__ void hgrn_store(const HgRegs& R, LAS unsigned char* base, int tid) {
#pragma unroll
    for (int i = 0; i < 2; ++i) { const int e = tid + 512 * i, row = e >> 4, ch = e & 15;
        *(LAS u32x4*)(base + HG_QT + row * 272 + ch * 16) = R.q[i];
        *(LAS u32x4*)(base + HG_KH + row * 272 + ch * 16) = R.k[i];
        *(LAS u32x4*)(base + HG_V + row * 272 + ch * 16) = R.v[i];
        *(LAS u32x4*)(base + HG_KT + e * 16) = R.t[i]; }
    if (tid < 128) *(LAS u32x4*)(base + HG_EB + tid * 16) = R.e;
}
__device__ __forceinline__ void hgrn_compute(LAS unsigned char* base, f32x4 (&S)[8], float* oA, int b, int h, int r, int wid, int lane) {
    const int l15 = lane & 15, g = lane >> 4;
#pragma unroll 1
    for (int ch = 0; ch < 4; ++ch) {
        bf16x8 Qf[4], Kf[4];
#pragma unroll
        for (int p = 0; p < 4; ++p) { const int off = ((16 * ch + l15) * 136 + 32 * p + 4 * g) * 2;
            const u32x2 a = *(const LAS u32x2*)(base + HG_QT + off), a2 = *(const LAS u32x2*)(base + HG_QT + off + 32);
            const u32x2 c = *(const LAS u32x2*)(base + HG_KH + off), c2 = *(const LAS u32x2*)(base + HG_KH + off + 32);
            u32x4 w; w.x = a.x; w.y = a.y; w.z = a2.x; w.w = a2.y; Qf[p] = __builtin_bit_cast(bf16x8, w);
            w.x = c.x; w.y = c.y; w.z = c2.x; w.w = c2.y; Kf[p] = __builtin_bit_cast(bf16x8, w); }
        f32x4 att = {0.f, 0.f, 0.f, 0.f};
#pragma unroll
        for (int p = 0; p < 4; ++p) att = __builtin_amdgcn_mfma_f32_16x16x32_bf16(Kf[p], Qf[p], att, 0, 0, 0);
#pragma unroll
        for (int j = 0; j < 4; ++j) att[j] = (4 * g + j <= l15) ? att[j] : 0.f;
        u32x2 aw; aw.x = pk2(att[0], att[1]); aw.y = pk2(att[2], att[3]);
        const bf16x4 attA = __builtin_bit_cast(bf16x4, aw);
        const LAS bf16_t* vp = (const LAS bf16_t*)(base + HG_V + (16 * ch + 4 * g) * 272 + (16 * wid + l15) * 2);
        u32x2 vw; vw.x = (unsigned)vp[0] | ((unsigned)vp[136] << 16); vw.y = (unsigned)vp[272] | ((unsigned)vp[408] << 16);
        const bf16x4 Vf = __builtin_bit_cast(bf16x4, vw);
        f32x4 o = {0.f, 0.f, 0.f, 0.f};
        o = __builtin_amdgcn_mfma_f32_16x16x16bf16_1k(attA, Vf, o, 0, 0, 0);
#pragma unroll
        for (int p = 0; p < 4; ++p) { u32x4 w; w.x = pk2(S[2 * p][0], S[2 * p][1]); w.y = pk2(S[2 * p][2], S[2 * p][3]); w.z = pk2(S[2 * p + 1][0], S[2 * p + 1][1]); w.w = pk2(S[2 * p + 1][2], S[2 * p + 1][3]);
            o = __builtin_amdgcn_mfma_f32_16x16x32_bf16(Qf[p], __builtin_bit_cast(bf16x8, w), o, 0, 0, 0); }
#pragma unroll
        for (int kt = 0; kt < 8; ++kt) { const f32x4 eb = *(const LAS f32x4*)(base + HG_EB + (ch * 128 + 16 * kt + 4 * g) * 4);
            const bf16x4 Kt = __builtin_bit_cast(bf16x4, *(const LAS u32x2*)(base + HG_KT + (ch * 128 + 16 * kt + l15) * 32 + 8 * g));
            S[kt] = __builtin_amdgcn_mfma_f32_16x16x16bf16_1k(Kt, Vf, S[kt] * eb, 0, 0, 0); }
        float* op = oA + (size_t)(b * SEQ + 64 * r + 16 * ch + 4 * g) * 512 + h * 128 + 16 * wid + l15;
#pragma unroll
        for (int j = 0; j < 4; ++j) op[(size_t)j * 512] = o[j];
    }
}
__device__ __forceinline__ void hgrn_block(LAS unsigned char* lds, const bf16_t* QTg, const bf16_t* KHg, const bf16_t* KTg, const float* EBg, const bf16_t* proj, float* oA, int b, int h, int tid, int wid, int lane) {
    f32x4 S[8];
#pragma unroll
    for (int i = 0; i < 8; ++i) S[i] = (f32x4){0.f, 0.f, 0.f, 0.f};
    HgRegs R;
    hgrn_load(R, QTg, KHg, KTg, EBg, proj, b, h, 0, tid);
    hgrn_store(R, lds, tid);
    __syncthreads();
#pragma unroll 1
    for (int r = 0; r < 32; ++r) {
        if (r + 1 < 32) hgrn_load(R, QTg, KHg, KTg, EBg, proj, b, h, r + 1, tid);
        hgrn_compute(lds + (r & 1) * HG_BUF, S, oA, b, h, r, wid, lane);
        if (r + 1 < 32) hgrn_store(R, lds + ((r + 1) & 1) * HG_BUF, tid);
        __syncthreads();
    }
}
__global__ void __launch_bounds__(NTHR, 2) fwd_megakernel(Ptrs P) {
    extern __shared__ __attribute__((aligned(16))) unsigned char lds_raw[];
    cg::grid_group grid = cg::this_grid();
    LAS unsigned char* lds = (LAS unsigned char*)lds_raw;
    int tid_ = threadIdx.x; asm volatile("" : "+v"(tid_));
    int tid = tid_, lane = tid & 63, wid = __builtin_amdgcn_readfirstlane(tid >> 6);
#define RETID() do { tid_ = threadIdx.x; asm volatile("" : "+v"(tid_)); tid = tid_; lane = tid & 63; wid = __builtin_amdgcn_readfirstlane(tid >> 6); } while (0)
    const int G = gridDim.x, bx = blockIdx.x;
    const int NGW = G * NWAVES;
#define gw (bx * NWAVES + wid)
    unsigned char* ws = P.ws;
    float* rope = (float*)(ws + WS_ROPE); float* lbs = (float*)(ws + WS_LBS);
    bf16_t* Win_t = (bf16_t*)(ws + WS_WIN); bf16_t* Wout_t = (bf16_t*)(ws + WS_WOUT); bf16_t* Wgu_t = (bf16_t*)(ws + WS_WGU); bf16_t* Wdn_t = (bf16_t*)(ws + WS_WDN);
    bf16_t* xb = (bf16_t*)(ws + WS_XB); float* xres = (float*)(ws + WS_XRES);
    bf16_t* proj = (bf16_t*)(ws + WS_PROJ); bf16_t* mixed = (bf16_t*)(ws + WS_MIXED); bf16_t* oBp = (bf16_t*)(ws + WS_OBP); float* oA = (float*)(ws + WS_OA); float* lseB = (float*)(ws + WS_LSE);
    bf16_t* gu = (bf16_t*)(ws + WS_GU);
    bf16_t* QTg = (bf16_t*)(ws + WS_QT); bf16_t* KHg = (bf16_t*)(ws + WS_KH); bf16_t* KTg = (bf16_t*)(ws + WS_KT); float* EBg = (float*)(ws + WS_EB);
    float* Z = P.out;

    convert_weights(P, 0, gw, NGW, lane);
    {
        const float* x = P.in[0];
        for (size_t i = (size_t)bx * NTHR + tid; i < (size_t)M_TOK * DM / 8; i += (size_t)G * NTHR) {
            const f32x4 a = *(const f32x4*)(x + i * 8), c = *(const f32x4*)(x + i * 8 + 4);
            u32x4 w; w.x = pk2(a[0], a[1]); w.y = pk2(a[2], a[3]); w.z = pk2(c[0], c[1]); w.w = pk2(c[2], c[3]);
            *(u32x4*)(xb + i * 8) = w; }
        const double CF[16] = {0.15915494309189535, 0.0700865215877985, 0.03086376340470123, 0.013591370636193905, 0.005985185712713705, 0.002635675898667414, 0.001160663641240061, 0.0005111175045375439,
                               0.00022507907903927653, 9.911730936901935e-05, 4.364795279280289e-05, 1.9221100684944863e-05, 8.464330808241401e-06, 3.727408601915352e-06, 1.6414262627950345e-06, 7.228293068832865e-07};
        for (int i = bx * NTHR + tid; i < SEQ * 16; i += G * NTHR) { const int pos = i >> 4, fi = i & 15;
            double cf = CF[0];
#pragma unroll
            for (int q = 1; q < 16; ++q) cf = (fi == q) ? CF[q] : cf;
            double rev = (double)pos * cf; rev -= __builtin_floor(rev); const float rv = (float)rev;
            rope[pos * 32 + fi] = __builtin_amdgcn_cosf(rv); rope[pos * 32 + 16 + fi] = __builtin_amdgcn_sinf(rv); }
        if (bx == 0) { const float* lg = P.in[2]; const float l0 = lg[tid], l1 = lg[512 + tid]; lbs[tid] = 0.f; lbs[512 + tid] = 1.f / (1.f + __expf(l0 - l1)); }
    }
    grid.sync();

#pragma unroll 1
    for (int l = 0; l < 2; ++l) {
        const float* resid = (l == 0) ? P.in[0] : xres;
        {
            pg8::Gemm g{xb, Win_t, M_TOK, INW, DM, DM}; pg8::StaticOrder S; S.init(M_TOK, INW, G, bx);
            pg8::EpiProj E{proj, INW, rope, QTg, KHg, KTg, EBg, lbs + l * 512};
            pg8::gemm_phase<pg8::EpiProj, pg8::StaticOrder, true, true>(lds, g, S, E);
        }
        grid.sync();
        RETID();
        {
            const int NH = (G > 32) ? 16 : 0;
            if (bx < NH || NH == 0) {
                for (int it = bx; it < 16; it += (NH ? NH : G)) hgrn_block(lds, QTg, KHg, KTg, EBg, proj, oA, it >> 2, it & 3, tid, wid, lane);
            }
            if (bx >= NH) {
                const float* sinks = P.in[4] + l * 6;
                for (int it = bx - NH; it < 1536; it += G - NH) {
                    const int type = it / 384, j = it % 384;
                    int b = j / 96, h = (j % 96) / 16, rr = j % 16;
                    if (type == 0) {
                        attn_item(lds, proj, b, 4352 + h * 128, 5120 + (h / 3) * 128, 5376 + (h / 3) * 128, 1, 0, rr, 127, true, sinks[h], mixed, DM, 1280 + h * 128, nullptr, tid, wid, lane);
                    } else {
                        const int p = type - 1; int dil, res, nb;
                        if (p == 0) { dil = 1; res = 0; nb = rr; } else if (p == 1) { dil = 4; res = rr >> 2; nb = rr & 3; } else { dil = 16; res = rr; nb = 0; }
                        attn_item(lds, proj, b, 2048 + h * 128, 2816 + h * 128, 3584 + h * 128, dil, res, nb, 128, false, 0.f, oBp + (size_t)p * M_TOK * 768, 768, h * 128, lseB + (size_t)p * M_TOK * 6 + h, tid, wid, lane);
                    }
                }
            }
        }
        grid.sync();
        RETID();
        {
            const float* nw = P.in[3] + l * 128;
            for (int row = gw; row < M_TOK; row += NGW) {
                { const float* op = oA + (size_t)row * 512 + 8 * lane; const f32x4 a = *(const f32x4*)op, c = *(const f32x4*)(op + 4);
                  float ss = (a[0] * a[0] + a[1] * a[1]) + (a[2] * a[2] + a[3] * a[3]) + (c[0] * c[0] + c[1] * c[1]) + (c[2] * c[2] + c[3] * c[3]);
                  ss += __shfl_xor(ss, 1); ss += __shfl_xor(ss, 2); ss += __shfl_xor(ss, 4); ss += __shfl_xor(ss, 8);
                  const float rstd = 1.f / sqrtf(ss * (1.f / 128.f) + LN_EPS);
                  const u32x4 gv = *(const u32x4*)(proj + (size_t)row * INW + 1536 + 8 * lane);
                  const f32x4 n0 = *(const f32x4*)(nw + (8 * lane & 127)), n1 = *(const f32x4*)(nw + (8 * lane & 127) + 4);
                  float o[8];
#pragma unroll
                  for (int i = 0; i < 8; ++i) { const float gg = __uint_as_float((i & 1) ? (gv[i >> 1] & 0xffff0000u) : (gv[i >> 1] << 16)); const float ov = (i < 4 ? a[i] : c[i - 4]), nn = (i < 4 ? n0[i] : n1[i - 4]);
                      o[i] = ov * rstd * nn * (gg / (1.f + __expf(-gg))); }
                  u32x4 w; w.x = pk2(o[0], o[1]); w.y = pk2(o[2], o[3]); w.z = pk2(o[4], o[5]); w.w = pk2(o[6], o[7]);
                  *(u32x4*)(mixed + (size_t)row * DM + 8 * lane) = w; }
#pragma unroll
                for (int rep = 0; rep < 2; ++rep) { const int chn = lane + 64 * rep;
                    if (chn < 96) { const int h = chn >> 4;
                        const float l0 = lseB[(size_t)row * 6 + h], l1 = lseB[((size_t)M_TOK + row) * 6 + h], l2 = lseB[((size_t)2 * M_TOK + row) * 6 + h];
                        const float mm = fmaxf(l0, fmaxf(l1, l2)); float w0 = __expf(l0 - mm), w1 = __expf(l1 - mm), w2 = __expf(l2 - mm); const float iw = 1.f / (w0 + w1 + w2); w0 *= iw; w1 *= iw; w2 *= iw;
                        const u32x4 a = *(const u32x4*)(oBp + (size_t)row * 768 + 8 * chn), c = *(const u32x4*)(oBp + ((size_t)M_TOK + row) * 768 + 8 * chn), d = *(const u32x4*)(oBp + ((size_t)2 * M_TOK + row) * 768 + 8 * chn);
                        u32x4 w;
#pragma unroll
                        for (int q = 0; q < 4; ++q) { const float lo = w0 * __uint_as_float(a[q] << 16) + w1 * __uint_as_float(c[q] << 16) + w2 * __uint_as_float(d[q] << 16);
                            const float hi = w0 * __uint_as_float(a[q] & 0xffff0000u) + w1 * __uint_as_float(c[q] & 0xffff0000u) + w2 * __uint_as_float(d[q] & 0xffff0000u); w[q] = pk2(lo, hi); }
                        *(u32x4*)(mixed + (size_t)row * DM + 512 + 8 * chn) = w; } }
            }
        }
        grid.sync();
        {
            pg8::Gemm g{mixed, Wout_t, M_TOK, DM, DM, DM}; pg8::StaticOrder S; S.init(M_TOK, DM, G, bx);
            pg8::EpiZ E{resid, Z, ALPHA};
            pg8::gemm_phase<pg8::EpiZ, pg8::StaticOrder, true, true>(lds, g, S, E);
        }
        grid.sync();
        RETID();
        for (int row = gw; row < M_TOK; row += NGW) ln_row(Z + (size_t)row * DM, P.in[6] + l * DM, P.in[7] + l * DM, xres + (size_t)row * DM, xb + (size_t)row * DM, lane);
        grid.sync();
        {
            pg8::Gemm g{xb, Wgu_t, M_TOK, GUW, DM, DM}; pg8::StaticOrder S; S.init(M_TOK, GUW, G, bx);
            pg8::EpiStore E{gu, GUW};
            pg8::gemm_phase<pg8::EpiStore, pg8::StaticOrder, true, true>(lds, g, S, E);
        }
        grid.sync();
        RETID();
        {
            const float* cw = P.in[10] + (size_t)l * 3 * FF; const float* cb = P.in[11] + (size_t)l * FF;
            for (int it = gw; it < 256 * 11; it += NGW) { const int rb = it / 11, cgp = it % 11, c0 = 512 * cgp + 8 * lane, m0 = 32 * rb;
                float w0[8], w1[8], w2[8], bb[8], g2[8], g1[8];
#pragma unroll
                for (int i = 0; i < 8; ++i) { w0[i] = cw[c0 + i]; w1[i] = cw[FF + c0 + i]; w2[i] = cw[2 * FF + c0 + i]; bb[i] = cb[c0 + i]; g2[i] = 0.f; g1[i] = 0.f; }
                if ((m0 & (SEQ - 1)) != 0) { const u32x4 a = *(const u32x4*)(gu + (size_t)(m0 - 2) * GUW + c0), c = *(const u32x4*)(gu + (size_t)(m0 - 1) * GUW + c0);
#pragma unroll
                    for (int q = 0; q < 4; ++q) { g2[2 * q] = __uint_as_float(a[q] << 16); g2[2 * q + 1] = __uint_as_float(a[q] & 0xffff0000u); g1[2 * q] = __uint_as_float(c[q] << 16); g1[2 * q + 1] = __uint_as_float(c[q] & 0xffff0000u); } }
#pragma unroll 4
                for (int i = 0; i < 32; ++i) { bf16_t* rp = gu + (size_t)(m0 + i) * GUW + c0; const u32x4 a = *(const u32x4*)rp, uu = *(const u32x4*)(rp + FF);
                    float g0[8], hh[8];
#pragma unroll
                    for (int q = 0; q < 4; ++q) { g0[2 * q] = __uint_as_float(a[q] << 16); g0[2 * q + 1] = __uint_as_float(a[q] & 0xffff0000u); }
#pragma unroll
                    for (int q = 0; q < 8; ++q) { const float gc = bb[q] + w0[q] * g2[q] + w1[q] * g1[q] + w2[q] * g0[q]; const float uv = __uint_as_float((q & 1) ? (uu[q >> 1] & 0xffff0000u) : (uu[q >> 1] << 16));
                        hh[q] = gc / (1.f + __expf(-gc)) * uv; g2[q] = g1[q]; g1[q] = g0[q]; }
                    u32x4 w; w.x = pk2(hh[0], hh[1]); w.y = pk2(hh[2], hh[3]); w.z = pk2(hh[4], hh[5]); w.w = pk2(hh[6], hh[7]);
                    *(u32x4*)(rp + FF) = w; }
            }
        }
        grid.sync();
        {
            pg8::Gemm g{gu + FF, Wdn_t, M_TOK, DM, FF, GUW}; pg8::StaticOrder S; S.init(M_TOK, DM, G, bx);
            pg8::EpiZ E{xres, Z, ALPHA};
            pg8::gemm_phase<pg8::EpiZ, pg8::StaticOrder, true, true>(lds, g, S, E);
        }
        grid.sync();
        RETID();
        if (l == 0) {
            for (int row = gw; row < M_TOK; row += NGW) ln_row(Z + (size_t)row * DM, P.in[13], P.in[14], xres + (size_t)row * DM, xb + (size_t)row * DM, lane);
            convert_weights(P, 1, gw, NGW, lane);
            grid.sync();
        } else {
            for (int row = gw; row < M_TOK; row += NGW) ln_row(Z + (size_t)row * DM, P.in[13] + DM, P.in[14] + DM, Z + (size_t)row * DM, nullptr, lane);
        }
    }
}

extern "C" void kernel_launch(void* const* d_in, const int* in_sizes, int n_in, void* d_out, int out_size, void* d_ws, size_t ws_size, hipStream_t stream) {
    static int grid_blocks = 0;
    if (grid_blocks == 0) {
        if (n_in != 15 || ws_size < WS_END) { fprintf(stderr, "kernel_launch: unexpected n_in %d / ws_size %zu\n", n_in, ws_size); grid_blocks = -1; return; }
        int dev = 0, cus = 0, per_cu = 0;
        hipGetDevice(&dev); hipDeviceGetAttribute(&cus, hipDeviceAttributeMultiprocessorCount, dev);
        hipFuncSetAttribute((const void*)fwd_megakernel, hipFuncAttributeMaxDynamicSharedMemorySize, LDS_BYTES);
        hipOccupancyMaxActiveBlocksPerMultiprocessor(&per_cu, (const void*)fwd_megakernel, NTHR, LDS_BYTES);
        if (per_cu < 1) { fprintf(stderr, "kernel_launch: occupancy query says %d blocks/CU\n", per_cu); per_cu = 1; }
        grid_blocks = cus;
        (void)hipGetLastError();
    }
    if (grid_blocks < 0) return;
    Ptrs p{};
    for (int i = 0; i < 15; ++i) p.in[i] = (const float*)d_in[i];
    p.out = (float*)d_out; p.ws = (unsigned char*)d_ws;
    void* args[] = {&p};
    hipError_t e = hipLaunchCooperativeKernel((const void*)fwd_megakernel, dim3(grid_blocks), dim3(NTHR), args, LDS_BYTES, stream);
    if (e != hipSuccess) fprintf(stderr, "cooperative launch failed: %s (grid %d)\n", hipGetErrorString(e), grid_blocks);
}
```

```cpp
#include <hip/hip_runtime.h>
#include <hip/hip_cooperative_groups.h>
#include <cstdio>
#include <cstdint>
namespace cg = cooperative_groups;
namespace pg8 {
#define PG8_LAS __attribute__((address_space(3)))
typedef unsigned short bf16_t;
typedef short bf16x8 __attribute__((ext_vector_type(8)));
typedef float f32x4 __attribute__((ext_vector_type(4)));
typedef unsigned u32x4 __attribute__((ext_vector_type(4)));
constexpr int BM = 256, BK = 64, HALF = 128, HTB = HALF * BK * 2  , STAGE_BYTES = 8 * HTB, NXCD = 8, WGM = 8;

__host__ __device__ __forceinline__ int lds_byte(int r, int c) { const int st = (r >> 4) * 2 + (c >> 5), rr = r & 15, cc = c & 31, ob = rr * 64 + cc * 2; return st * 1024 + (ob ^ (((ob >> 9) & 1) << 5)); }
__host__ __device__ __forceinline__ void stage_rc(int b, int& R, int& C) { const int st = b / 1024, sb = b % 1024, swz = sb ^ (((sb >> 9) & 1) << 5); R = (st >> 1) * 16 + swz / 64; C = (st & 1) * 32 + (swz % 64) / 2; }
__host__ __device__ __forceinline__ int perm32(int rho) { const int n = rho >> 4, i = rho & 15; return 8 * (i >> 2) + 4 * n + (i & 3); }

struct Unit { int pm, pn; };

struct StaticOrder {
    int nM, nN, nwg, G, c;
    __host__ __device__ void init(int M, int N, int G_, int c_) { nM = M / BM; nN = N / BM; nwg = nM * nN; G = G_; c = c_; }
    __host__ __device__ bool next(int i, Unit& u) const {
        const long L = (long)i * G + c; if (L >= nwg) return false;
        int wgid = (int)L; { const int q = nwg / NXCD, r = nwg % NXCD, xcd = wgid % NXCD, off = wgid / NXCD; wgid = (xcd < r ? xcd * (q + 1) : r * (q + 1) + (xcd - r) * q) + off; }
        const int nig = WGM * nN, gid = wgid / nig, fm = gid * WGM, gsz = (nM - fm) < WGM ? (nM - fm) : WGM;
        u.pm = fm + ((wgid % nig) % gsz); u.pn = (wgid % nig) / gsz; return true;
    }
    __device__ __forceinline__ void a_ready(const Unit&) const {}
    __device__ __forceinline__ void done(const Unit&) const {}
};

struct Gemm { const bf16_t* A; const bf16_t* Bt; int M, N, K, lda; };
__device__ __forceinline__ unsigned cvt_pk_bf16(float lo, float hi) { unsigned r; asm volatile("v_cvt_pk_bf16_f32 %0, %1, %2" : "=v"(r) : "v"(lo), "v"(hi)); return r; }

struct EpiStore {
    static constexpr bool PERM = true, AFTER_DRAIN = false;
    bf16_t* O; int ldc;
    __device__ __forceinline__ void operator()(const f32x4 (&acc)[2][2][4][2], const Unit& u, int wr, int wc, int fr, int fq) const {
        const int row0 = u.pm * BM + wr * 64 + fr; const int col0 = u.pn * BM + wc * 32 + 8 * fq;
#pragma unroll
        for (int ai = 0; ai < 2; ++ai)
#pragma unroll
            for (int m = 0; m < 4; ++m) { bf16_t* rowp = O + (size_t)(row0 + ai * HALF + m * 16) * ldc + col0;
#pragma unroll
                for (int bj = 0; bj < 2; ++bj) { const f32x4 v0 = acc[ai][bj][m][0], v1 = acc[ai][bj][m][1];
                    u32x4 w; w.x = cvt_pk_bf16(v0[0], v0[1]); w.y = cvt_pk_bf16(v0[2], v0[3]); w.z = cvt_pk_bf16(v1[0], v1[1]); w.w = cvt_pk_bf16(v1[2], v1[3]);
                    *(u32x4*)(rowp + bj * HALF) = w; } }
    }
};
template <int CTRL> __device__ __forceinline__ float row_shr_fill1(float v) { return __int_as_float(__builtin_amdgcn_update_dpp(0x3f800000, __float_as_int(v), CTRL, 0xf, 0xf, false)); }
struct EpiProj {
    static constexpr bool PERM = true, AFTER_DRAIN = false;
    bf16_t* O; int ldc; const float* rope;
    bf16_t* QTg; bf16_t* KHg; bf16_t* KTg; float* EBg; const float* lb;
    __device__ __forceinline__ void hgrn(const f32x4 (&acc)[2][2][4][2], const Unit& u, int wr, int wc, int fr, int fq) const {
        const int h = u.pn, kb = h * 128 + wc * 32 + 8 * fq, lane = fq * 16 + fr;
        const f32x4 lb0 = *(const f32x4*)(lb + kb), lb1 = *(const f32x4*)(lb + kb + 4);
#pragma unroll
        for (int ai = 0; ai < 2; ++ai)
#pragma unroll
            for (int m = 0; m < 4; ++m) { const int row = u.pm * BM + ai * HALF + wr * 64 + m * 16 + fr, chunk = row >> 4;
                float qt[8], kh[8], kt[8], el[8];
#pragma unroll
                for (int n = 0; n < 2; ++n)
#pragma unroll
                    for (int i = 0; i < 4; ++i) { const int ix = 4 * n + i; const float q = acc[ai][0][m][n][i]; float fl = acc[ai][1][m][n][i]; const float lbk = n ? lb1[i] : lb0[i];
                        fl = fminf(fmaxf(fl, -30.f), 30.f);
                        const float e = __expf(-fl), sg = __builtin_amdgcn_rcpf(1.f + e), oml = 1.f - lbk, f = lbk + oml * sg, kk = oml * e * sg;
                        float E = f;
                        E *= row_shr_fill1<0x111>(E); E *= row_shr_fill1<0x112>(E); E *= row_shr_fill1<0x114>(E); E *= row_shr_fill1<0x118>(E);
                        const float El = __shfl(E, (lane & 48) | 15);
                        const float qh = q * __builtin_amdgcn_rcpf(1.f + __expf(-q));
                        const float iE = __builtin_amdgcn_rcpf(E);
                        qt[ix] = qh * E; kh[ix] = kk * iE; kt[ix] = kh[ix] * El; el[ix] = El; }
                u32x4 w; w.x = cvt_pk_bf16(qt[0], qt[1]); w.y = cvt_pk_bf16(qt[2], qt[3]); w.z = cvt_pk_bf16(qt[4], qt[5]); w.w = cvt_pk_bf16(qt[6], qt[7]);
                *(u32x4*)(QTg + (size_t)row * 512 + kb) = w;
                w.x = cvt_pk_bf16(kh[0], kh[1]); w.y = cvt_pk_bf16(kh[2], kh[3]); w.z = cvt_pk_bf16(kh[4], kh[5]); w.w = cvt_pk_bf16(kh[6], kh[7]);
                *(u32x4*)(KHg + (size_t)row * 512 + kb) = w;
                bf16_t* ktp = KTg + ((size_t)chunk * 512 + kb) * 16 + fr;
#pragma unroll
                for (int ix = 0; ix < 8; ix += 2) { const unsigned pr = cvt_pk_bf16(kt[ix], kt[ix + 1]); ktp[ix * 16] = (bf16_t)(pr & 0xffffu); ktp[(ix + 1) * 16] = (bf16_t)(pr >> 16); }
                if (fr == 0) { float* ep = EBg + (size_t)chunk * 512 + kb; *(f32x4*)ep = (f32x4){el[0], el[1], el[2], el[3]}; *(f32x4*)(ep + 4) = (f32x4){el[4], el[5], el[6], el[7]}; }
            }
    }
    __device__ __forceinline__ void operator()(const f32x4 (&acc)[2][2][4][2], const Unit& u, int wr, int wc, int fr, int fq) const {
        if (u.pn < 4) { hgrn(acc, u, wr, wc, fr, fq); return; }
        const int row0 = u.pm * BM + wr * 64 + fr; const int col0 = u.pn * BM + wc * 32 + 8 * fq;
        bool rp[2];
#pragma unroll
        for (int bj = 0; bj < 2; ++bj) { const int cb = u.pn * BM + bj * HALF; rp[bj] = (wc == 0) && ((cb >= 2048 && cb < 3584) || (cb >= 4352 && cb < 5376)); }
        const bool anyr = rp[0] || rp[1];
        const float sgn = (fq < 2) ? -1.f : 1.f;
#pragma unroll
        for (int ai = 0; ai < 2; ++ai)
#pragma unroll
            for (int m = 0; m < 4; ++m) { const int row = row0 + ai * HALF + m * 16; bf16_t* rowp = O + (size_t)row * ldc + col0;
                f32x4 c0 = {1.f, 1.f, 1.f, 1.f}, c1 = c0, s0 = {0.f, 0.f, 0.f, 0.f}, s1 = s0;
                if (anyr) { const float* rt = rope + (size_t)(row & 2047) * 32 + 8 * (fq & 1);
                    c0 = *(const f32x4*)(rt); c1 = *(const f32x4*)(rt + 4); s0 = *(const f32x4*)(rt + 16); s1 = *(const f32x4*)(rt + 20); }
#pragma unroll
                for (int bj = 0; bj < 2; ++bj) { f32x4 v0 = acc[ai][bj][m][0], v1 = acc[ai][bj][m][1];
                    if (rp[bj]) {
                        f32x4 p0, p1;
#pragma unroll
                        for (int i = 0; i < 4; ++i) { p0[i] = __shfl_xor(v0[i], 32); p1[i] = __shfl_xor(v1[i], 32); }
                        v0 = v0 * c0 + (p0 * s0) * sgn; v1 = v1 * c1 + (p1 * s1) * sgn;
                    }
                    u32x4 w; w.x = cvt_pk_bf16(v0[0], v0[1]); w.y = cvt_pk_bf16(v0[2], v0[3]); w.z = cvt_pk_bf16(v1[0], v1[1]); w.w = cvt_pk_bf16(v1[2], v1[3]);
                    *(u32x4*)(rowp + bj * HALF) = w; } }
    }
};
struct EpiZ {
    static constexpr bool PERM = false, AFTER_DRAIN = false;
    const float* res; float* Z; float alpha;
    __device__ __forceinline__ void operator()(const f32x4 (&acc)[2][2][4][2], const Unit& u, int wr, int wc, int fr, int fq) const {
        const int col0 = u.pn * BM + wc * 32 + 4 * fq;
#pragma unroll
        for (int ai = 0; ai < 2; ++ai)
#pragma unroll
            for (int m = 0; m < 4; ++m) { const int r = u.pm * BM + ai * HALF + wr * 64 + m * 16 + fr; const size_t off = (size_t)r * 2048 + col0;
#pragma unroll
                for (int bj = 0; bj < 2; ++bj)
#pragma unroll
                    for (int n = 0; n < 2; ++n) { const f32x4 bs = *(const f32x4*)(res + off + bj * HALF + n * 16); const f32x4 o = bs * alpha + acc[ai][bj][m][n]; *(f32x4*)(Z + off + bj * HALF + n * 16) = o; } }
    }
};
template <class Epi, class Sched, bool ALIGN_EPI = false, bool SP2 = false>
__device__ __forceinline__ void gemm_phase(PG8_LAS unsigned char* lds, const Gemm g, const Sched& S, const Epi& E) {
    int tid_ = threadIdx.x; asm volatile("" : "+v"(tid_));
    const int tid = tid_, wid = __builtin_amdgcn_readfirstlane(tid >> 6), lane = tid & 63, wr = wid >> 2, wc = wid & 3, fr = lane & 15, fq = lane >> 4;
    const int K = g.K, nt = K / BK, lda = g.lda;
    unsigned voffA[2], voffB[2];
#pragma unroll
    for (int i = 0; i < 2; ++i) { int R, C; stage_rc(tid * 16 + i * 8192, R, C); const int Rb = Epi::PERM ? ((R & ~31) + perm32(R & 31)) : R;
        voffA[i] = (unsigned)(R * lda + C) * 2u; voffB[i] = (unsigned)(Rb * K + C) * 2u; }
    const size_t kstep = (size_t)(BK * 2);
    const size_t hstep = (size_t)HALF * K * 2;
    const size_t tstep = 2 * hstep; const size_t hstepA = (size_t)HALF * lda * 2, tstepA = 2 * hstepA;
    const unsigned ldsw = (unsigned)wid * 1024u;
    const int aoff = lds_byte(wr * 64 + fr, fq * 8), boff = lds_byte(wc * 32 + fr, fq * 8);
#define PG8_SA(b, h) (((b) * 2 + (h)) * HTB)
#define PG8_SB(b, h) ((4 + (b) * 2 + (h)) * HTB)
#define PG8_STAGE(bufoff, gbase, voff) do { _Pragma("unroll") for (int _i = 0; _i < 2; ++_i) \
        __builtin_amdgcn_global_load_lds((const unsigned*)((const char*)(gbase) + (voff)[_i]), (PG8_LAS unsigned*)(lds + (bufoff) + ldsw + _i * 8192), 16, 0, 0); } while (0)
#define PG8_LDA(dst, b, h) do { _Pragma("unroll") for (int m = 0; m < 4; ++m) _Pragma("unroll") for (int k = 0; k < 2; ++k) dst[m][k] = *(const PG8_LAS bf16x8*)(lds + PG8_SA(b, h) + aoff + m * 2048 + k * 1024); } while (0)
#define PG8_LDB(dst, b, h) do { _Pragma("unroll") for (int n = 0; n < 2; ++n) _Pragma("unroll") for (int k = 0; k < 2; ++k) dst[n][k] = *(const PG8_LAS bf16x8*)(lds + PG8_SB(b, h) + boff + n * 2048 + k * 1024); } while (0)
#define PG8_MMA(ai, bj, At, Bt) do { __builtin_amdgcn_s_setprio(1); _Pragma("unroll") for (int m = 0; m < 4; ++m) _Pragma("unroll") for (int n = 0; n < 2; ++n) _Pragma("unroll") for (int k = 0; k < 2; ++k) \
        acc[ai][bj][m][n] = __builtin_amdgcn_mfma_f32_16x16x32_bf16(Bt[n][k], At[m][k], acc[ai][bj][m][n], 0, 0, 0); __builtin_amdgcn_s_setprio(0); } while (0)
#define PG8_WAIT_V(n) asm volatile("s_waitcnt vmcnt(" #n ")" ::: "memory")
#define PG8_WAIT_L(n) asm volatile("s_waitcnt lgkmcnt(" #n ")" ::: "memory")
#define PG8_BAR __builtin_amdgcn_s_barrier()
#define PG8_SCHED __builtin_amdgcn_sched_barrier(0)
    Unit cur, nxt; int ui = 0;
    if (!S.next(0, cur)) return;
    f32x4 acc[2][2][4][2];
#pragma unroll
    for (int a = 0; a < 2; ++a)
#pragma unroll
        for (int b = 0; b < 2; ++b)
#pragma unroll
            for (int m = 0; m < 4; ++m)
#pragma unroll
                for (int n = 0; n < 2; ++n) acc[a][b][m][n] = (f32x4){0.f, 0.f, 0.f, 0.f};
    bf16x8 At[4][2], B0[2][2], B1[2][2];
    const char* cA = (const char*)g.A + (size_t)cur.pm * tstepA; const char* cB = (const char*)g.Bt + (size_t)cur.pn * tstep;
    S.a_ready(cur);
    if constexpr (SP2) {
        PG8_STAGE(PG8_SB(0, 0), cB, voffB); PG8_STAGE(PG8_SB(0, 1), cB + hstep, voffB); PG8_STAGE(PG8_SA(0, 0), cA, voffA); PG8_STAGE(PG8_SA(0, 1), cA + hstepA, voffA);
        if (wr == 1) PG8_BAR;
        PG8_WAIT_V(2); PG8_BAR;
        PG8_STAGE(PG8_SB(1, 0), cB + kstep, voffB); PG8_STAGE(PG8_SA(1, 0), cA + kstep, voffA); PG8_STAGE(PG8_SB(1, 1), cB + hstep + kstep, voffB);
        PG8_WAIT_V(6); PG8_BAR;
    } else {
        PG8_STAGE(PG8_SB(0, 0), cB, voffB); PG8_STAGE(PG8_SA(0, 0), cA, voffA); PG8_STAGE(PG8_SB(0, 1), cB + hstep, voffB); PG8_STAGE(PG8_SA(0, 1), cA + hstepA, voffA);
        if (wr == 1) PG8_BAR;
        PG8_WAIT_V(4); PG8_BAR;
        PG8_STAGE(PG8_SB(1, 0), cB + kstep, voffB); PG8_STAGE(PG8_SA(1, 0), cA + kstep, voffA); PG8_STAGE(PG8_SB(1, 1), cB + hstep + kstep, voffB);
        PG8_WAIT_V(6); PG8_BAR;
    }
    for (;;) {
        const bool has_next = S.next(ui + 1, nxt);
        const char* nA = has_next ? (const char*)g.A + (size_t)nxt.pm * tstepA : cA; const char* nB = has_next ? (const char*)g.Bt + (size_t)nxt.pn * tstep : cB;
        for (int t = 0; t < nt; t += 2) {
            const bool last = (t == nt - 2);
            const char* a1 = cA + (size_t)(t + 1) * kstep;
            const char* a2 = last ? nA : cA + (size_t)(t + 2) * kstep; const char* b2 = last ? nB : cB + (size_t)(t + 2) * kstep;
            const char* a3 = a2 + kstep; const char* b3 = b2 + kstep;
            if (last && has_next) S.a_ready(nxt);
            if constexpr (SP2) {
            PG8_LDB(B0, 0, 0); PG8_LDB(B1, 0, 1); PG8_SCHED; PG8_LDA(At, 0, 0); PG8_STAGE(PG8_SA(1, 1), a1 + hstepA, voffA);
            PG8_WAIT_V(8); PG8_WAIT_L(0); PG8_BAR; PG8_MMA(0, 0, At, B0); PG8_MMA(0, 1, At, B1); PG8_BAR; PG8_SCHED;
            PG8_LDA(At, 0, 1); PG8_STAGE(PG8_SB(0, 0), b2, voffB); PG8_STAGE(PG8_SB(0, 1), b2 + hstep, voffB); PG8_STAGE(PG8_SA(0, 0), a2, voffA);
            PG8_WAIT_V(8); PG8_WAIT_L(0); PG8_BAR; PG8_MMA(1, 0, At, B0); PG8_MMA(1, 1, At, B1); PG8_BAR; PG8_SCHED;
            PG8_LDB(B0, 1, 0); PG8_LDB(B1, 1, 1); PG8_SCHED; PG8_LDA(At, 1, 0); PG8_STAGE(PG8_SA(0, 1), a2 + hstepA, voffA);
            PG8_WAIT_V(8); PG8_WAIT_L(0); PG8_BAR; PG8_MMA(0, 0, At, B0); PG8_MMA(0, 1, At, B1); PG8_BAR; PG8_SCHED;
            PG8_LDA(At, 1, 1); PG8_STAGE(PG8_SB(1, 0), b3, voffB); PG8_STAGE(PG8_SB(1, 1), b3 + hstep, voffB); PG8_STAGE(PG8_SA(1, 0), a3, voffA);
            PG8_WAIT_V(8); PG8_WAIT_L(0); PG8_BAR; PG8_MMA(1, 0, At, B0); PG8_MMA(1, 1, At, B1); PG8_BAR; PG8_SCHED;
            } else {
            PG8_LDB(B0, 0, 0); PG8_SCHED; PG8_LDA(At, 0, 0); PG8_STAGE(PG8_SA(1, 1), a1 + hstepA, voffA);
            PG8_WAIT_L(8); PG8_BAR; PG8_WAIT_L(0); PG8_MMA(0, 0, At, B0); PG8_BAR; PG8_SCHED;
            PG8_LDB(B1, 0, 1); PG8_STAGE(PG8_SB(0, 0), b2, voffB);
            PG8_BAR; PG8_WAIT_L(0); PG8_MMA(0, 1, At, B1); PG8_BAR;
            PG8_LDA(At, 0, 1); PG8_STAGE(PG8_SA(0, 0), a2, voffA);
            PG8_BAR; PG8_WAIT_L(0); PG8_MMA(1, 0, At, B0); PG8_BAR; PG8_SCHED;
            PG8_STAGE(PG8_SB(0, 1), b2 + hstep, voffB);
            PG8_WAIT_V(6); PG8_BAR; PG8_MMA(1, 1, At, B1); PG8_BAR;
            PG8_LDB(B0, 1, 0); PG8_SCHED; PG8_LDA(At, 1, 0); PG8_STAGE(PG8_SA(0, 1), a2 + hstepA, voffA);
            PG8_WAIT_L(8); PG8_BAR; PG8_WAIT_L(0); PG8_MMA(0, 0, At, B0); PG8_BAR; PG8_SCHED;
            PG8_LDB(B1, 1, 1); PG8_STAGE(PG8_SB(1, 0), b3, voffB);
            PG8_BAR; PG8_WAIT_L(0); PG8_MMA(0, 1, At, B1); PG8_BAR;
            PG8_LDA(At, 1, 1); PG8_STAGE(PG8_SA(1, 0), a3, voffA);
            PG8_BAR; PG8_WAIT_L(0); PG8_MMA(1, 0, At, B0); PG8_BAR; PG8_SCHED;
            PG8_STAGE(PG8_SB(1, 1), b3 + hstep, voffB);
            PG8_WAIT_V(6); PG8_BAR; PG8_MMA(1, 1, At, B1); PG8_BAR;
            }
        }
        if constexpr (ALIGN_EPI) { if (wr == 0) PG8_BAR; }
        if constexpr (!Epi::AFTER_DRAIN) { E(acc, cur, wr, wc, fr, fq); S.done(cur); }
        if (!has_next) break;
#pragma unroll
        for (int a = 0; a < 2; ++a)
#pragma unroll
            for (int b = 0; b < 2; ++b)
#pragma unroll
                for (int m = 0; m < 4; ++m)
#pragma unroll
                    for (int n = 0; n < 2; ++n) acc[a][b][m][n] = (f32x4){0.f, 0.f, 0.f, 0.f};
        cur = nxt; cA = nA; cB = nB; ++ui;
        if constexpr (ALIGN_EPI) { if (wr == 1) PG8_BAR; }
    }
    PG8_WAIT_V(0);
    if constexpr (!ALIGN_EPI) { if (wr == 0) PG8_BAR; }
    PG8_BAR;
    if constexpr (Epi::AFTER_DRAIN) { E.fused(acc, cur, wr, wc, fr, fq, lds, wid, lane); S.done(cur); }
#undef PG8_SA
#undef PG8_SB
#undef PG8_STAGE
#undef PG8_LDA
#undef PG8_LDB
#undef PG8_MMA
#undef PG8_WAIT_V
#undef PG8_WAIT_L
#undef PG8_BAR
#undef PG8_SCHED
}
}
#define LAS __attribute__((address_space(3)))
typedef unsigned short bf16_t;
typedef short bf16x8 __attribute__((ext_vector_type(8)));
typedef short bf16x4 __attribute__((ext_vector_type(4)));
typedef float f32x4 __attribute__((ext_vector_type(4)));
typedef unsigned u32x4 __attribute__((ext_vector_type(4)));
typedef unsigned u32x2 __attribute__((ext_vector_type(2)));
constexpr int M_TOK = 8192, SEQ = 2048, DM = 2048, INW = 5632, FF = 5632, GUW = 11264;
constexpr float ALPHA = 1.4142135623730951f, LN_EPS = 1e-5f;
constexpr size_t MiB = 1u << 20;
constexpr size_t WS_ROPE = 64 * 1024, WS_LBS = 320 * 1024;
constexpr size_t WS_WIN = 1 * MiB, WS_WOUT = 23 * MiB, WS_WGU = 31 * MiB, WS_WDN = 75 * MiB;
constexpr size_t WS_XB = 97 * MiB, WS_XRES = 129 * MiB, WS_R = 193 * MiB;
constexpr size_t WS_PROJ = WS_R, WS_MIXED = WS_R + 88 * MiB, WS_OBP = WS_R + 120 * MiB, WS_OA = WS_R + 156 * MiB, WS_LSE = WS_R + 172 * MiB;
constexpr size_t WS_GU = WS_R;
constexpr size_t WS_QT = WS_R + 173 * MiB, WS_KH = WS_R + 181 * MiB, WS_KT = WS_R + 189 * MiB, WS_EB = WS_R + 197 * MiB;
constexpr size_t WS_END = 448 * MiB;
constexpr int LDS_BYTES = 141312 + 1024;
constexpr int NWAVES = 8, NTHR = 512;

__device__ __forceinline__ float bf2f(unsigned short v) { return __uint_as_float((unsigned)v << 16); }
__device__ __forceinline__ unsigned f2bf(float f) { unsigned u = __float_as_uint(f); return (u + 0x7fffu + ((u >> 16) & 1u)) >> 16; }
__device__ __forceinline__ unsigned pk2(float lo, float hi) { return pg8::cvt_pk_bf16(lo, hi); }
__device__ __forceinline__ float wave_sum(float v) {
#pragma unroll
    for (int o = 1; o < 64; o <<= 1) v += __shfl_xor(v, o);
    return v;
}
#define LDS_WAIT() asm volatile("s_waitcnt lgkmcnt(0)" ::: "memory")

__device__ __forceinline__ void transpose_item(const float* W, int K, int N, bf16_t* WT, int k0, int n0, int new_n0, int lane) {
    typedef float f32x2 __attribute__((ext_vector_type(2)));
    const float* src = W + (size_t)k0 * N + n0 + 2 * lane;
    bf16_t* d0 = WT + (size_t)(new_n0 + 2 * lane) * K + k0; bf16_t* d1 = d0 + K;
#pragma unroll
    for (int hb = 0; hb < 2; ++hb) {
        f32x2 v[32];
#pragma unroll
        for (int i = 0; i < 32; ++i) v[i] = __builtin_nontemporal_load((const f32x2*)(src + (size_t)(32 * hb + i) * N));
#pragma unroll
        for (int q = 0; q < 4; ++q) { u32x4 a, c;
            a.x = pk2(v[8 * q][0], v[8 * q + 1][0]); a.y = pk2(v[8 * q + 2][0], v[8 * q + 3][0]); a.z = pk2(v[8 * q + 4][0], v[8 * q + 5][0]); a.w = pk2(v[8 * q + 6][0], v[8 * q + 7][0]);
            c.x = pk2(v[8 * q][1], v[8 * q + 1][1]); c.y = pk2(v[8 * q + 2][1], v[8 * q + 3][1]); c.z = pk2(v[8 * q + 4][1], v[8 * q + 5][1]); c.w = pk2(v[8 * q + 6][1], v[8 * q + 7][1]);
            *(u32x4*)(d0 + 32 * hb + 8 * q) = a; *(u32x4*)(d1 + 32 * hb + 8 * q) = c; }
    }
}

struct Ptrs {
    const float* in[15]; float* out; unsigned char* ws;
};

__device__ __forceinline__ void convert_weights(const Ptrs& P, int l, int gw, int NGW, int lane) {
    constexpr int I_IN = 32 * 44, I_OUT = 32 * 16, I_G = 32 * 44, I_D = 88 * 16;
    constexpr int NITEMS = I_IN + I_OUT + 2 * I_G + I_D;
    bf16_t* Win_t = (bf16_t*)(P.ws + WS_WIN); bf16_t* Wout_t = (bf16_t*)(P.ws + WS_WOUT); bf16_t* Wgu_t = (bf16_t*)(P.ws + WS_WGU); bf16_t* Wdn_t = (bf16_t*)(P.ws + WS_WDN);
    const float* w_in = P.in[1] + (size_t)l * DM * INW; const float* w_out = P.in[5] + (size_t)l * DM * DM;
    const float* w_gate = P.in[8] + (size_t)l * DM * FF; const float* w_up = P.in[9] + (size_t)l * DM * FF; const float* w_down = P.in[12] + (size_t)l * FF * DM;
    for (int it = gw; it < NITEMS; it += NGW) {
        int r = it;
        if (r < I_IN) { const int kb = r / 44, nb = r % 44, n0 = 128 * nb; const int nn = (nb < 8) ? ((nb & 3) * 256 + (nb >> 2) * 128) : n0;
            transpose_item(w_in, DM, INW, Win_t, 64 * kb, n0, nn, lane); continue; } r -= I_IN;
        if (r < I_OUT) { transpose_item(w_out, DM, DM, Wout_t, 64 * (r / 16), 128 * (r % 16), 128 * (r % 16), lane); continue; } r -= I_OUT;
        if (r < I_G) { transpose_item(w_gate, DM, FF, Wgu_t, 64 * (r / 44), 128 * (r % 44), 128 * (r % 44), lane); continue; } r -= I_G;
        if (r < I_G) { transpose_item(w_up, DM, FF, Wgu_t, 64 * (r / 44), 128 * (r % 44), FF + 128 * (r % 44), lane); continue; } r -= I_G;
        transpose_item(w_down, FF, DM, Wdn_t, 64 * (r / 16), 128 * (r % 16), 128 * (r % 16), lane);
    }
}

__device__ __forceinline__ void ln_row(const float* zrow, const float* gam, const float* bet, float* out_f, bf16_t* out_b, int lane) {
    f32x4 v[8]; float s = 0.f;
#pragma unroll
    for (int j = 0; j < 8; ++j) { v[j] = *(const f32x4*)(zrow + 4 * lane + 256 * j); s += (v[j][0] + v[j][1]) + (v[j][2] + v[j][3]); }
    const float mean = wave_sum(s) * (1.f / 2048.f); float s2 = 0.f;
#pragma unroll
    for (int j = 0; j < 8; ++j) { v[j] = v[j] - mean; s2 += (v[j][0] * v[j][0] + v[j][1] * v[j][1]) + (v[j][2] * v[j][2] + v[j][3] * v[j][3]); }
    const float rstd = 1.f / sqrtf(wave_sum(s2) * (1.f / 2048.f) + LN_EPS);
#pragma unroll
    for (int j = 0; j < 8; ++j) { const f32x4 gg = *(const f32x4*)(gam + 4 * lane + 256 * j), bb = *(const f32x4*)(bet + 4 * lane + 256 * j);
        const f32x4 o = v[j] * rstd * gg + bb;
        if (out_f) *(f32x4*)(out_f + 4 * lane + 256 * j) = o;
        if (out_b) { u32x2 w; w.x = pk2(o[0], o[1]); w.y = pk2(o[2], o[3]); *(u32x2*)(out_b + 4 * lane + 256 * j) = w; } }
}

__device__ __forceinline__ void attn_item(LAS unsigned char* lds, const bf16_t* proj, int b, int qcol, int kcol, int vcol, int dil, int res, int nb, int maxlag,
                                          bool hasSink, float sink, bf16_t* out, int ldo, int ocol, float* lsep, int tid, int wid, int lane) {
    constexpr int KROW = 272, VROW = 528;
    LAS unsigned char* Ks = lds; LAS unsigned char* Vs = lds + 256 * KROW;
    const int tk0 = (nb - 1) * 128;
#pragma unroll
    for (int i = 0; i < 8; ++i) { const int e = tid + 512 * i, key = e >> 4, ch = e & 15, tau = tk0 + key;
        u32x4 v = {0u, 0u, 0u, 0u};
        if (tau >= 0) v = *(const u32x4*)(proj + (size_t)(b * SEQ + tau * dil + res) * INW + kcol + ch * 8);
        *(LAS u32x4*)(Ks + key * KROW + ch * 16) = v; }
#pragma unroll
    for (int i = 0; i < 4; ++i) { const int e = tid + 512 * i, ch = (e & 1) | (((e >> 6) & 7) << 1), kp = ((e >> 1) & 31) | ((e >> 9) << 5), tau0 = tk0 + 2 * kp;
        u32x4 a = {0u, 0u, 0u, 0u}, c = {0u, 0u, 0u, 0u};
        if (tau0 >= 0) { a = *(const u32x4*)(proj + (size_t)(b * SEQ + tau0 * dil + res) * INW + vcol + ch * 8); c = *(const u32x4*)(proj + (size_t)(b * SEQ + (tau0 + 1) * dil + res) * INW + vcol + ch * 8); }
#pragma unroll
        for (int q = 0; q < 4; ++q) {
            *(LAS unsigned*)(Vs + (ch * 8 + 2 * q) * VROW + kp * 4) = (a[q] & 0xffffu) | (c[q] << 16);
            *(LAS unsigned*)(Vs + (ch * 8 + 2 * q + 1) * VROW + kp * 4) = (a[q] >> 16) | (c[q] & 0xffff0000u); } }
    __syncthreads();
    const int l15 = lane & 15, g = lane >> 4;
    const int r = 16 * wid + l15, tq = (nb * 128 + r) * dil + res; const size_t qrow = (size_t)b * SEQ + tq;
    bf16x8 Qf[4];
#pragma unroll
    for (int kk = 0; kk < 4; ++kk) Qf[kk] = *(const bf16x8*)(proj + qrow * INW + qcol + 32 * kk + 8 * g);
    f32x4 S[10];
#pragma unroll
    for (int i = 0; i < 10; ++i) { const int kt = wid + i, ktc = kt < 15 ? kt : 15; f32x4 acc = {0.f, 0.f, 0.f, 0.f};
#pragma unroll
        for (int kk = 0; kk < 4; ++kk) { const bf16x8 A = *(const LAS bf16x8*)(Ks + (16 * ktc + l15) * KROW + (32 * kk + 8 * g) * 2); acc = __builtin_amdgcn_mfma_f32_16x16x32_bf16(A, Qf[kk], acc, 0, 0, 0); }
        S[i] = acc; }
    const float scale = 0.08838834764831845f;
    float mx = -1e30f;
#pragma unroll
    for (int i = 0; i < 10; ++i)
#pragma unroll
        for (int j = 0; j < 4; ++j) { const int c = 16 * (wid + i) + 4 * g + j, lag = 128 + r - c; const bool valid = (wid + i < 16) && lag >= 0 && lag <= maxlag && (tk0 + c >= 0);
            const float s = valid ? S[i][j] * scale : -1e30f; S[i][j] = s; mx = fmaxf(mx, s); }
    mx = fmaxf(mx, __shfl_xor(mx, 16)); mx = fmaxf(mx, __shfl_xor(mx, 32));
    if (hasSink) mx = fmaxf(mx, sink);
    float sum = 0.f;
#pragma unroll
    for (int i = 0; i < 10; ++i)
#pragma unroll
        for (int j = 0; j < 4; ++j) { const float p = __expf(S[i][j] - mx); S[i][j] = p; sum += p; }
    sum += __shfl_xor(sum, 16); sum += __shfl_xor(sum, 32);
    if (hasSink) sum += __expf(sink - mx);
    bf16x8 Pf[5];
#pragma unroll
    for (int sl = 0; sl < 5; ++sl) { u32x4 w; w.x = pk2(S[2 * sl][0], S[2 * sl][1]); w.y = pk2(S[2 * sl][2], S[2 * sl][3]); w.z = pk2(S[2 * sl + 1][0], S[2 * sl + 1][1]); w.w = pk2(S[2 * sl + 1][2], S[2 * sl + 1][3]); Pf[sl] = __builtin_bit_cast(bf16x8, w); }
    const float inv = 1.f / sum;
#pragma unroll
    for (int dt = 0; dt < 8; ++dt) { f32x4 acc = {0.f, 0.f, 0.f, 0.f}; const int d = 16 * dt + l15;
#pragma unroll
        for (int sl = 0; sl < 5; ++sl) { const int k0 = (wid + 2 * sl) < 15 ? (wid + 2 * sl) : 15, k1 = (wid + 2 * sl + 1) < 15 ? (wid + 2 * sl + 1) : 15;
            const u32x2 lo = *(const LAS u32x2*)(Vs + d * VROW + (16 * k0 + 4 * g) * 2), hi = *(const LAS u32x2*)(Vs + d * VROW + (16 * k1 + 4 * g) * 2);
            u32x4 w; w.x = lo.x; w.y = lo.y; w.z = hi.x; w.w = hi.y;
            acc = __builtin_amdgcn_mfma_f32_16x16x32_bf16(__builtin_bit_cast(bf16x8, w), Pf[sl], acc, 0, 0, 0); }
        acc = acc * inv; u32x2 w; w.x = pk2(acc[0], acc[1]); w.y = pk2(acc[2], acc[3]);
        *(u32x2*)(out + qrow * ldo + ocol + 16 * dt + 4 * g) = w; }
    if (lsep && g == 0) lsep[qrow * 6] = mx + __logf(sum);
    __syncthreads();
}

constexpr int HG_QT = 0, HG_KH = 17408, HG_V = 34816, HG_KT = 52224, HG_EB = 68608, HG_BUF = 70656;
struct HgRegs { u32x4 q[2], k[2], v[2], t[2], e; };
__device__ __forceinline__ void hgrn_load(HgRegs& R, const bf16_t* QTg, const bf16_t* KHg, const bf16_t* KTg, const float* EBg, const bf16_t* proj, int b, int h, int r, int tid) {
    const size_t row0 = (size_t)b * SEQ + 64 * r; const size_t c0 = row0 >> 4;
#pragma unroll
    for (int i = 0; i < 2; ++i) { const int e = tid + 512 * i, row = e >> 4, ch = e & 15;
        R.q[i] = *(const u32x4*)(QTg + (row0 + row) * 512 + h * 128 + ch * 8);
        R.k[i] = *(const u32x4*)(KHg + (row0 + row) * 512 + h * 128 + ch * 8);
        R.v[i] = *(const u32x4*)(proj + (row0 + row) * INW + 1024 + h * 128 + ch * 8);
        const int chk = e >> 8, wi = e & 255;
        R.t[i] = *(const u32x4*)(KTg + ((c0 + chk) * 512 + h * 128) * 16 + wi * 8); }
    R.e = (u32x4){0u, 0u, 0u, 0u};
    if (tid < 128) { const int chk = tid >> 5, wi = tid & 31; R.e = *(const u32x4*)(EBg + (c0 + chk) * 512 + h * 128 + wi * 4); }
}
__device__ __forceinline__ void hgrn_store(const HgRegs& R, LAS unsigned char* base, int tid) {
#pragma unroll
    for (int i = 0; i < 2; ++i) { const int e = tid + 512 * i, row = e >> 4, ch = e & 15;
        *(LAS u32x4*)(base + HG_QT + row * 272 + ch * 16) = R.q[i];
        *(LAS u32x4*)(base + HG_KH + row * 272 + ch * 16) = R.k[i];
        *(LAS u32x4*)(base + HG_V + row * 272 + ch * 16) = R.v[i];
        *(LAS u32x4*)(base + HG_KT + e * 16) = R.t[i]; }
    if (tid < 128) *(LAS u32x4*)(base + HG_EB + tid * 16) = R.e;
}
__device__ __forceinline__ void hgrn_compute(LAS unsigned char* base, f32x4 (&S)[8], float* oA, int b, int h, int r, int wid, int lane) {
    const int l15 = lane & 15, g = lane >> 4;
    bf16x4 Vf[4]; f32x4 o[4];
#pragma unroll
    for (int ch = 0; ch < 4; ++ch) {
        bf16x8 Kf[4], Qf[4];
#pragma unroll
        for (int p = 0; p < 4; ++p) { const int off = ((16 * ch + l15) * 136 + 32 * p + 4 * g) * 2;
            const u32x2 a = *(const LAS u32x2*)(base + HG_QT + off), a2 = *(const LAS u32x2*)(base + HG_QT + off + 32);
            const u32x2 c = *(const LAS u32x2*)(base + HG_KH + off), c2 = *(const LAS u32x2*)(base + HG_KH + off + 32);
            u32x4 w; w.x = a.x; w.y = a.y; w.z = a2.x; w.w = a2.y; Qf[p] = __builtin_bit_cast(bf16x8, w);
            w.x = c.x; w.y = c.y; w.z = c2.x; w.w = c2.y; Kf[p] = __builtin_bit_cast(bf16x8, w); }
        const LAS bf16_t* vp = (const LAS bf16_t*)(base + HG_V + (16 * ch + 4 * g) * 272 + (16 * wid + l15) * 2);
        u32x2 vw; vw.x = (unsigned)vp[0] | ((unsigned)vp[136] << 16); vw.y = (unsigned)vp[272] | ((unsigned)vp[408] << 16);
        Vf[ch] = __builtin_bit_cast(bf16x4, vw);
        f32x4 att = {0.f, 0.f, 0.f, 0.f};
#pragma unroll
        for (int p = 0; p < 4; ++p) att = __builtin_amdgcn_mfma_f32_16x16x32_bf16(Kf[p], Qf[p], att, 0, 0, 0);
#pragma unroll
        for (int j = 0; j < 4; ++j) att[j] = (4 * g + j <= l15) ? att[j] : 0.f;
        u32x2 aw; aw.x = pk2(att[0], att[1]); aw.y = pk2(att[2], att[3]);
        o[ch] = __builtin_amdgcn_mfma_f32_16x16x16bf16_1k(__builtin_bit_cast(bf16x4, aw), Vf[ch], (f32x4){0.f, 0.f, 0.f, 0.f}, 0, 0, 0);
        asm volatile("" ::: "memory");
    }
#pragma unroll
    for (int ch = 0; ch < 4; ++ch) {
        f32x4 eb[8]; bf16x4 Kt[8]; bf16x8 Qf[4];
#pragma unroll
        for (int p = 0; p < 4; ++p) { const int off = ((16 * ch + l15) * 136 + 32 * p + 4 * g) * 2;
            const u32x2 a = *(const LAS u32x2*)(base + HG_QT + off), a2 = *(const LAS u32x2*)(base + HG_QT + off + 32);
            u32x4 w; w.x = a.x; w.y = a.y; w.z = a2.x; w.w = a2.y; Qf[p] = __builtin_bit_cast(bf16x8, w); }
#pragma unroll
        for (int kt = 0; kt < 8; ++kt) { eb[kt] = *(const LAS f32x4*)(base + HG_EB + (ch * 128 + 16 * kt + 4 * g) * 4);
            Kt[kt] = __builtin_bit_cast(bf16x4, *(const LAS u32x2*)(base + HG_KT + (ch * 128 + 16 * kt + l15) * 32 + 8 * g)); }
        f32x4 o2 = {0.f, 0.f, 0.f, 0.f};
#pragma unroll
        for (int p = 0; p < 4; ++p) { u32x4 w; w.x = pk2(S[2 * p][0], S[2 * p][1]); w.y = pk2(S[2 * p][2], S[2 * p][3]); w.z = pk2(S[2 * p + 1][0], S[2 * p + 1][1]); w.w = pk2(S[2 * p + 1][2], S[2 * p + 1][3]);
            if (p & 1) o2 = __builtin_amdgcn_mfma_f32_16x16x32_bf16(Qf[p], __builtin_bit_cast(bf16x8, w), o2, 0, 0, 0);
            else o[ch] = __builtin_amdgcn_mfma_f32_16x16x32_bf16(Qf[p], __builtin_bit_cast(bf16x8, w), o[ch], 0, 0, 0); }
#pragma unroll
        for (int kt = 0; kt < 8; ++kt) S[kt] = __builtin_amdgcn_mfma_f32_16x16x16bf16_1k(Kt[kt], Vf[ch], S[kt] * eb[kt], 0, 0, 0);
        const f32x4 ov = o[ch] + o2;
        float* op = oA + (size_t)(b * SEQ + 64 * r + 16 * ch + 4 * g) * 512 + h * 128 + 16 * wid + l15;
#pragma unroll
        for (int j = 0; j < 4; ++j) op[(size_t)j * 512] = ov[j];
        asm volatile("" ::: "memory");
    }
}
__device__ __forceinline__ void hgrn_block(LAS unsigned char* lds, const bf16_t* QTg, const bf16_t* KHg, const bf16_t* KTg, const float* EBg, const bf16_t* proj, float* oA, int b, int h, int tid, int wid, int lane) {
    f32x4 S[8];
#pragma unroll
    for (int i = 0; i < 8; ++i) S[i] = (f32x4){0.f, 0.f, 0.f, 0.f};
    HgRegs R;
    hgrn_load(R, QTg, KHg, KTg, EBg, proj, b, h, 0, tid);
    hgrn_store(R, lds, tid);
    __syncthreads();
#pragma unroll 1
    for (int r = 0; r < 32; ++r) {
        if (r + 1 < 32) hgrn_load(R, QTg, KHg, KTg, EBg, proj, b, h, r + 1, tid);
        hgrn_compute(lds + (r & 1) * HG_BUF, S, oA, b, h, r, wid, lane);
        if (r + 1 < 32) hgrn_store(R, lds + ((r + 1) & 1) * HG_BUF, tid);
        __syncthreads();
    }
}
typedef __attribute__((address_space(1))) unsigned gu32;
#define XB_TMO      128
#define XB_XCNT(j)  (256  + 64 * (j))
#define XB_XSUB(j)  (1280 + 64 * (j))
#define XB_XGEN(j)  (2304 + 64 * (j))
#define XB_TOP      3328
#define XB_TOPGEN   3392
#define XCD_BAR_WORDS 3456
#define XB_SPIN_CAP (1u << 18)

__device__ __forceinline__ unsigned xb_ld(unsigned* p)              { return __hip_atomic_load(p, __ATOMIC_RELAXED, __HIP_MEMORY_SCOPE_AGENT); }
__device__ __forceinline__ unsigned xb_add(unsigned* p, unsigned v) { return __hip_atomic_fetch_add(p, v, __ATOMIC_RELAXED, __HIP_MEMORY_SCOPE_AGENT); }
__device__ __forceinline__ unsigned xb_xcc_id() { return (unsigned)__builtin_amdgcn_s_getreg((3 << 11) | 20) & 0xFu; }
#define XB_SPIN(cond, bar) do { unsigned _sp = 0; while (cond) { __builtin_amdgcn_s_sleep(1); \
    if ((++_sp & 255u) == 0u) { if (xb_ld(&(bar)[XB_TMO])) break; if (_sp > XB_SPIN_CAP) { atomicAdd(&(bar)[XB_TMO], 1u); break; } } } } while (0)

struct XcdBarrier {
    unsigned* bar; unsigned x;
    volatile LAS unsigned* st;
};

__device__ __forceinline__ XcdBarrier xcd_barrier_post(unsigned* bar, volatile LAS unsigned* st) {
    XcdBarrier b; b.bar = bar; b.x = xb_xcc_id(); b.st = st;
    if (threadIdx.x == 0) (void)xb_add(&bar[XB_XCNT(b.x)], 1u);
    return b;
}
__device__ __forceinline__ void xcd_barrier_complete(unsigned* bar, unsigned x, unsigned& nloc, unsigned& nx) {
    const unsigned G = gridDim.x * gridDim.y * gridDim.z;
    unsigned sum, cnt, mine, sp = 0u;
    for (;;) {
        sum = 0u; cnt = 0u; mine = 0u;
#pragma unroll
        for (unsigned j = 0; j < 16; ++j) { const unsigned c = xb_ld(&bar[XB_XCNT(j)]); sum += c; cnt += (c > 0u) ? 1u : 0u; mine = (j == x) ? c : mine; }
        if (sum == G) break;
        __builtin_amdgcn_s_sleep(1);
        if ((++sp & 255u) == 0u) { if (xb_ld(&bar[XB_TMO])) break; if (sp > XB_SPIN_CAP) { atomicAdd(&bar[XB_TMO], 1u); break; } }
    }
    nloc = mine > 0u ? mine : 1u; nx = cnt > 0u ? cnt : 1u;
}

__device__ __forceinline__ void xcd_barrier(const XcdBarrier& b) {
    asm volatile("s_waitcnt vmcnt(0)" ::: "memory");
    __syncthreads();
    if (threadIdx.x == 0) {
        unsigned* bar = b.bar;
        __builtin_amdgcn_s_waitcnt(0);
        unsigned nloc = b.st[0], nx = b.st[1];
        if (nloc == 0u) { xcd_barrier_complete(bar, b.x, nloc, nx); b.st[0] = nloc; b.st[1] = nx; }
        const unsigned old = xb_add(&bar[XB_XSUB(b.x)], 1u);
        const unsigned gen = old / nloc;
        if (old + 1u == (gen + 1u) * nloc) {
            __builtin_amdgcn_fence(__ATOMIC_RELEASE, "agent");
            asm volatile("s_waitcnt vmcnt(0)" ::: "memory");
            const unsigned og = xb_add(&bar[XB_TOP], 1u);
            const unsigned tg = og / nx;
            if (og + 1u == (tg + 1u) * nx) xb_add(&bar[XB_TOPGEN], 1u);
            else XB_SPIN(xb_ld(&bar[XB_TOPGEN]) == tg, bar);
            __builtin_amdgcn_fence(__ATOMIC_ACQUIRE, "agent");
            xb_add(&bar[XB_XGEN(b.x)], 1u);
            asm volatile("s_waitcnt vmcnt(0)" ::: "memory");
        } else {
            XB_SPIN(xb_ld(&bar[XB_XGEN(b.x)]) == gen, bar);
            __builtin_amdgcn_fence(__ATOMIC_ACQUIRE, "agent");
            asm volatile("s_waitcnt vmcnt(0)" ::: "memory");
        }
    }
    __syncthreads();
}

#ifndef PHASE_MASK
#define PHASE_MASK 0xffff
#endif
#ifndef PROBE_ATT
#define PROBE_ATT 1
#endif
#ifndef PROBE_HG
#define PROBE_HG 1
#endif
#ifndef PROBE_P2A
#define PROBE_P2A 1
#endif
#ifndef PROBE_SYNC
#define PROBE_SYNC 1
#endif
#ifndef PROBE_CVT
#define PROBE_CVT 1
#endif
#define GSYNC() do { for (int s_ = 0; s_ < PROBE_SYNC; ++s_) xcd_barrier(xbar); } while (0)
__global__ void __launch_bounds__(NTHR, 2) fwd_megakernel(Ptrs P) {
    extern __shared__ __attribute__((aligned(16))) unsigned char lds_raw[];
    cg::grid_group grid = cg::this_grid();
    LAS unsigned char* lds = (LAS unsigned char*)lds_raw;
    int tid_ = threadIdx.x; asm volatile("" : "+v"(tid_));
    int tid = tid_, lane = tid & 63, wid = __builtin_amdgcn_readfirstlane(tid >> 6);
#define RETID() do { tid_ = threadIdx.x; asm volatile("" : "+v"(tid_)); tid = tid_; lane = tid & 63; wid = __builtin_amdgcn_readfirstlane(tid >> 6); } while (0)
    const int G = gridDim.x, bx = blockIdx.x;
    if (tid_ < 32) ((LAS unsigned*)(lds + 141312))[tid_] = 0u;
    __syncthreads();
    const XcdBarrier xbar = xcd_barrier_post((unsigned*)P.ws, (volatile LAS unsigned*)(lds + 141312 + 32));
    const int NGW = G * NWAVES;
#define gw (bx * NWAVES + wid)
#define WSB() ({ size_t z_ = 0; asm volatile("" : "+s"(z_)); P.ws + z_; })
#define rope ((float*)(WSB() + WS_ROPE))
#define lbs ((float*)(WSB() + WS_LBS))
#define Win_t ((bf16_t*)(WSB() + WS_WIN))
#define Wout_t ((bf16_t*)(WSB() + WS_WOUT))
#define Wgu_t ((bf16_t*)(WSB() + WS_WGU))
#define Wdn_t ((bf16_t*)(WSB() + WS_WDN))
#define xb ((bf16_t*)(WSB() + WS_XB))
#define xres ((float*)(WSB() + WS_XRES))
#define proj ((bf16_t*)(WSB() + WS_PROJ))
#define mixed ((bf16_t*)(WSB() + WS_MIXED))
#define oBp ((bf16_t*)(WSB() + WS_OBP))
#define oA ((float*)(WSB() + WS_OA))
#define lseB ((float*)(WSB() + WS_LSE))
#define gu ((bf16_t*)(WSB() + WS_GU))
#define QTg ((bf16_t*)(WSB() + WS_QT))
#define KHg ((bf16_t*)(WSB() + WS_KH))
#define KTg ((bf16_t*)(WSB() + WS_KT))
#define EBg ((float*)(WSB() + WS_EB))
#define Z (P.out)

    for (int c_ = 0; c_ < PROBE_CVT; ++c_) convert_weights(P, 0, gw, NGW, lane);
    {
        const float* x = P.in[0]; bf16_t* const xb_ = xb; float* const rope_ = rope; float* const lbs_ = lbs;
        for (size_t i = (size_t)bx * NTHR + tid; i < (size_t)M_TOK * DM / 8; i += (size_t)G * NTHR) {
            const f32x4 a = *(const f32x4*)(x + i * 8), c = *(const f32x4*)(x + i * 8 + 4);
            u32x4 w; w.x = pk2(a[0], a[1]); w.y = pk2(a[2], a[3]); w.z = pk2(c[0], c[1]); w.w = pk2(c[2], c[3]);
            *(u32x4*)(xb_ + i * 8) = w; }
        const double CF[16] = {0.15915494309189535, 0.0700865215877985, 0.03086376340470123, 0.013591370636193905, 0.005985185712713705, 0.002635675898667414, 0.001160663641240061, 0.0005111175045375439,
                               0.00022507907903927653, 9.911730936901935e-05, 4.364795279280289e-05, 1.9221100684944863e-05, 8.464330808241401e-06, 3.727408601915352e-06, 1.6414262627950345e-06, 7.228293068832865e-07};
        for (int i = bx * NTHR + tid; i < SEQ * 16; i += G * NTHR) { const int pos = i >> 4, fi = i & 15;
            double cf = CF[0];
#pragma unroll
            for (int q = 1; q < 16; ++q) cf = (fi == q) ? CF[q] : cf;
            double rev = (double)pos * cf; rev -= __builtin_floor(rev); const float rv = (float)rev;
            rope_[pos * 32 + fi] = __builtin_amdgcn_cosf(rv); rope_[pos * 32 + 16 + fi] = __builtin_amdgcn_sinf(rv); }
        if (bx == 0) { const float* lg = P.in[2]; const float l0 = lg[tid], l1 = lg[512 + tid]; lbs_[tid] = 0.f; lbs_[512 + tid] = 1.f / (1.f + __expf(l0 - l1)); }
    }
    grid.sync();

#pragma unroll 1
    for (int l = 0; l < 2; ++l) {
        if (PHASE_MASK & (1 << 1))
        {
            pg8::Gemm g{xb, Win_t, M_TOK, INW, DM, DM}; pg8::StaticOrder S; S.init(M_TOK, INW, G, bx);
            pg8::EpiProj E{proj, INW, rope, QTg, KHg, KTg, EBg, lbs + l * 512};
            pg8::gemm_phase<pg8::EpiProj, pg8::StaticOrder, true, true>(lds, g, S, E);
        }
        GSYNC();
        RETID();
        if (PHASE_MASK & (1 << 2))
        {
            for (int rep_ = 0; rep_ < PROBE_P2A; ++rep_) {
            const int NH = (G > 32) ? 16 : 0;
            unsigned char* const wsl = WSB(); bf16_t* const proj_ = (bf16_t*)(wsl + WS_PROJ); bf16_t* const mixed_ = (bf16_t*)(wsl + WS_MIXED); bf16_t* const oBp_ = (bf16_t*)(wsl + WS_OBP); float* const lseB_ = (float*)(wsl + WS_LSE);
            if (bx < NH || NH == 0) {
                for (int it = bx; it < 16 * PROBE_HG; it += (NH ? NH : G)) hgrn_block(lds, (bf16_t*)(wsl + WS_QT), (bf16_t*)(wsl + WS_KH), (bf16_t*)(wsl + WS_KT), (float*)(wsl + WS_EB), proj_, (float*)(wsl + WS_OA), (it & 15) >> 2, it & 3, tid, wid, lane);
            }
            if (bx >= NH) {
                const float* sinks = P.in[4] + l * 6;
                for (int it = bx - NH; it < 1536; it += G - NH) {
                    const int type = it / 384, j = it % 384;
                    int b = j / 96, h = (j % 96) / 16, rr = j % 16;
                    int qcol, kcol, vcol, dil = 1, res = 0, nb = rr, maxlag = 128, ldo = 768, ocol = h * 128; bool hs = false; float sk = 0.f; bf16_t* outp; float* lsep = nullptr;
                    if (type == 0) { qcol = 4352 + h * 128; kcol = 5120 + (h / 3) * 128; vcol = kcol + 256; maxlag = 127; hs = true; sk = sinks[h]; outp = mixed_; ldo = DM; ocol = 1280 + h * 128; }
                    else { const int p = type - 1; qcol = 2048 + h * 128; kcol = qcol + 768; vcol = qcol + 1536;
                        if (p == 1) { dil = 4; res = rr >> 2; nb = rr & 3; } else if (p == 2) { dil = 16; res = rr; nb = 0; }
                        outp = oBp_ + (size_t)p * M_TOK * 768; lsep = lseB_ + (size_t)p * M_TOK * 6 + h; }
                    for (int ra_ = 0; ra_ < PROBE_ATT; ++ra_) attn_item(lds, proj_, b, qcol, kcol, vcol, dil, res, nb, maxlag, hs, sk, outp, ldo, ocol, lsep, tid, wid, lane);
                }
            }
            }
        }
        GSYNC();
        RETID();
        if (PHASE_MASK & (1 << 3))
        {
            const float* nw = P.in[3] + l * 128;
            unsigned char* const wsl = WSB(); const bf16_t* const proj_ = (const bf16_t*)(wsl + WS_PROJ); bf16_t* const mixed_ = (bf16_t*)(wsl + WS_MIXED); const bf16_t* const oBp_ = (const bf16_t*)(wsl + WS_OBP); const float* const lseB_ = (const float*)(wsl + WS_LSE); const float* const oA_ = (const float*)(wsl + WS_OA);
            for (int row = gw; row < M_TOK; row += NGW) {
                { const float* op = oA_ + (size_t)row * 512 + 8 * lane; const f32x4 a = *(const f32x4*)op, c = *(const f32x4*)(op + 4);
                  float ss = (a[0] * a[0] + a[1] * a[1]) + (a[2] * a[2] + a[3] * a[3]) + (c[0] * c[0] + c[1] * c[1]) + (c[2] * c[2] + c[3] * c[3]);
                  ss += __shfl_xor(ss, 1); ss += __shfl_xor(ss, 2); ss += __shfl_xor(ss, 4); ss += __shfl_xor(ss, 8);
                  const float rstd = 1.f / sqrtf(ss * (1.f / 128.f) + LN_EPS);
                  const u32x4 gv = *(const u32x4*)(proj_ + (size_t)row * INW + 1536 + 8 * lane);
                  const f32x4 n0 = *(const f32x4*)(nw + (8 * lane & 127)), n1 = *(const f32x4*)(nw + (8 * lane & 127) + 4);
                  float o[8];
#pragma unroll
                  for (int i = 0; i < 8; ++i) { const float gg = __uint_as_float((i & 1) ? (gv[i >> 1] & 0xffff0000u) : (gv[i >> 1] << 16)); const float ov = (i < 4 ? a[i] : c[i - 4]), nn = (i < 4 ? n0[i] : n1[i - 4]);
                      o[i] = ov * rstd * nn * (gg / (1.f + __expf(-gg))); }
                  u32x4 w; w.x = pk2(o[0], o[1]); w.y = pk2(o[2], o[3]); w.z = pk2(o[4], o[5]); w.w = pk2(o[6], o[7]);
                  *(u32x4*)(mixed_ + (size_t)row * DM + 8 * lane) = w; }
#pragma unroll
                for (int rep = 0; rep < 2; ++rep) { const int chn = lane + 64 * rep;
                    if (chn < 96) { const int h = chn >> 4;
                        const float l0 = lseB_[(size_t)row * 6 + h], l1 = lseB_[((size_t)M_TOK + row) * 6 + h], l2 = lseB_[((size_t)2 * M_TOK + row) * 6 + h];
                        const float mm = fmaxf(l0, fmaxf(l1, l2)); float w0 = __expf(l0 - mm), w1 = __expf(l1 - mm), w2 = __expf(l2 - mm); const float iw = 1.f / (w0 + w1 + w2); w0 *= iw; w1 *= iw; w2 *= iw;
                        const u32x4 a = *(const u32x4*)(oBp_ + (size_t)row * 768 + 8 * chn), c = *(const u32x4*)(oBp_ + ((size_t)M_TOK + row) * 768 + 8 * chn), d = *(const u32x4*)(oBp_ + ((size_t)2 * M_TOK + row) * 768 + 8 * chn);
                        u32x4 w;
#pragma unroll
                        for (int q = 0; q < 4; ++q) { const float lo = w0 * __uint_as_float(a[q] << 16) + w1 * __uint_as_float(c[q] << 16) + w2 * __uint_as_float(d[q] << 16);
                            const float hi = w0 * __uint_as_float(a[q] & 0xffff0000u) + w1 * __uint_as_float(c[q] & 0xffff0000u) + w2 * __uint_as_float(d[q] & 0xffff0000u); w[q] = pk2(lo, hi); }
                        *(u32x4*)(mixed_ + (size_t)row * DM + 512 + 8 * chn) = w; } }
            }
        }
        GSYNC();
        if (PHASE_MASK & (1 << 4))
        {
            pg8::Gemm g{mixed, Wout_t, M_TOK, DM, DM, DM}; pg8::StaticOrder S; S.init(M_TOK, DM, G, bx);
            pg8::EpiZ E{(l == 0) ? P.in[0] : (const float*)xres, Z, ALPHA};
            pg8::gemm_phase<pg8::EpiZ, pg8::StaticOrder, true, true>(lds, g, S, E);
        }
        GSYNC();
        RETID();
        { float* const xres_ = xres; bf16_t* const xb_ = xb; for (int row = gw; row < M_TOK; row += NGW) ln_row(Z + (size_t)row * DM, P.in[6] + l * DM, P.in[7] + l * DM, xres_ + (size_t)row * DM, xb_ + (size_t)row * DM, lane); }
        GSYNC();
        if (PHASE_MASK & (1 << 5))
        {
            pg8::Gemm g{xb, Wgu_t, M_TOK, GUW, DM, DM}; pg8::StaticOrder S; S.init(M_TOK, GUW, G, bx);
            pg8::EpiStore E{gu, GUW};
            pg8::gemm_phase<pg8::EpiStore, pg8::StaticOrder, true, true>(lds, g, S, E);
        }
        GSYNC();
        RETID();
        if (PHASE_MASK & (1 << 6))
        {
            const float* cw = P.in[10] + (size_t)l * 3 * FF; const float* cb = P.in[11] + (size_t)l * FF; bf16_t* const gu_ = gu;
            for (int it = gw; it < 256 * 11; it += NGW) { const int rb = it / 11, cgp = it % 11, c0 = 512 * cgp + 8 * lane, m0 = 32 * rb;
                float w0[8], w1[8], w2[8], bb[8], g2[8], g1[8];
#pragma unroll
                for (int i = 0; i < 8; ++i) { w0[i] = cw[c0 + i]; w1[i] = cw[FF + c0 + i]; w2[i] = cw[2 * FF + c0 + i]; bb[i] = cb[c0 + i]; g2[i] = 0.f; g1[i] = 0.f; }
                if ((m0 & (SEQ - 1)) != 0) { const u32x4 a = *(const u32x4*)(gu_ + (size_t)(m0 - 2) * GUW + c0), c = *(const u32x4*)(gu_ + (size_t)(m0 - 1) * GUW + c0);
#pragma unroll
                    for (int q = 0; q < 4; ++q) { g2[2 * q] = __uint_as_float(a[q] << 16); g2[2 * q + 1] = __uint_as_float(a[q] & 0xffff0000u); g1[2 * q] = __uint_as_float(c[q] << 16); g1[2 * q + 1] = __uint_as_float(c[q] & 0xffff0000u); } }
#pragma unroll 4
                for (int i = 0; i < 32; ++i) { bf16_t* rp = gu_ + (size_t)(m0 + i) * GUW + c0; const u32x4 a = *(const u32x4*)rp, uu = *(const u32x4*)(rp + FF);
                    float g0[8], hh[8];
#pragma unroll
                    for (int q = 0; q < 4; ++q) { g0[2 * q] = __uint_as_float(a[q] << 16); g0[2 * q + 1] = __uint_as_float(a[q] & 0xffff0000u); }
#pragma unroll
                    for (int q = 0; q < 8; ++q) { const float gc = bb[q] + w0[q] * g2[q] + w1[q] * g1[q] + w2[q] * g0[q]; const float uv = __uint_as_float((q & 1) ? (uu[q >> 1] & 0xffff0000u) : (uu[q >> 1] << 16));
                        hh[q] = gc / (1.f + __expf(-gc)) * uv; g2[q] = g1[q]; g1[q] = g0[q]; }
                    u32x4 w; w.x = pk2(hh[0], hh[1]); w.y = pk2(hh[2], hh[3]); w.z = pk2(hh[4], hh[5]); w.w = pk2(hh[6], hh[7]);
                    *(u32x4*)(rp + FF) = w; }
            }
        }
        GSYNC();
        if (PHASE_MASK & (1 << 7))
        {
            pg8::Gemm g{gu + FF, Wdn_t, M_TOK, DM, FF, GUW}; pg8::StaticOrder S; S.init(M_TOK, DM, G, bx);
            pg8::EpiZ E{xres, Z, ALPHA};
            pg8::gemm_phase<pg8::EpiZ, pg8::StaticOrder, true, true>(lds, g, S, E);
        }
        GSYNC();
        RETID();
        if (l == 0) {
            { float* const xres_ = xres; bf16_t* const xb_ = xb; for (int row = gw; row < M_TOK; row += NGW) ln_row(Z + (size_t)row * DM, P.in[13], P.in[14], xres_ + (size_t)row * DM, xb_ + (size_t)row * DM, lane); }
            convert_weights(P, 1, gw, NGW, lane);
            GSYNC();
        } else {
            for (int row = gw; row < M_TOK; row += NGW) ln_row(Z + (size_t)row * DM, P.in[13] + DM, P.in[14] + DM, Z + (size_t)row * DM, nullptr, lane);
        }
    }
}

extern "C" void kernel_launch(void* const* d_in, const int* in_sizes, int n_in, void* d_out, int out_size, void* d_ws, size_t ws_size, hipStream_t stream) {
    static int grid_blocks = 0;
    if (grid_blocks == 0) {
        if (n_in != 15 || ws_size < WS_END) { fprintf(stderr, "kernel_launch: unexpected n_in %d / ws_size %zu\n", n_in, ws_size); grid_blocks = -1; return; }
        int dev = 0, cus = 0, per_cu = 0;
        hipGetDevice(&dev); hipDeviceGetAttribute(&cus, hipDeviceAttributeMultiprocessorCount, dev);
        hipFuncSetAttribute((const void*)fwd_megakernel, hipFuncAttributeMaxDynamicSharedMemorySize, LDS_BYTES);
        hipOccupancyMaxActiveBlocksPerMultiprocessor(&per_cu, (const void*)fwd_megakernel, NTHR, LDS_BYTES);
        if (per_cu < 1) { fprintf(stderr, "kernel_launch: occupancy query says %d blocks/CU\n", per_cu); per_cu = 1; }
        grid_blocks = cus;
        (void)hipGetLastError();
    }
    if (grid_blocks < 0) return;
    if (hipMemsetAsync(d_ws, 0, 16384, stream) != hipSuccess) { fprintf(stderr, "memset failed\n"); return; }
    Ptrs p{};
    for (int i = 0; i < 15; ++i) p.in[i] = (const float*)d_in[i];
    p.out = (float*)d_out; p.ws = (unsigned char*)d_ws;
    void* args[] = {&p};
    hipError_t e = hipLaunchCooperativeKernel((const void*)fwd_megakernel, dim3(grid_blocks), dim3(NTHR), args, LDS_BYTES, stream);
    if (e != hipSuccess) fprintf(stderr, "cooperative launch failed: %s (grid %d)\n", hipGetErrorString(e), grid_blocks);
}
```

```cpp
#include <hip/hip_runtime.h>
#include <hip/hip_cooperative_groups.h>
#include <cstdio>
#include <cstdint>
namespace cg = cooperative_groups;
namespace pg8 {
#define PG8_LAS __attribute__((address_space(3)))
typedef unsigned short bf16_t;
typedef short bf16x8 __attribute__((ext_vector_type(8)));
typedef float f32x4 __attribute__((ext_vector_type(4)));
typedef unsigned u32x4 __attribute__((ext_vector_type(4)));
constexpr int BM = 256, BK = 64, HALF = 128, HTB = HALF * BK * 2  , STAGE_BYTES = 8 * HTB, NXCD = 8, WGM = 8;

__host__ __device__ __forceinline__ int lds_byte(int r, int c) { const int st = (r >> 4) * 2 + (c >> 5), rr = r & 15, cc = c & 31, ob = rr * 64 + cc * 2; return st * 1024 + (ob ^ (((ob >> 9) & 1) << 5)); }
__host__ __device__ __forceinline__ void stage_rc(int b, int& R, int& C) { const int st = b / 1024, sb = b % 1024, swz = sb ^ (((sb >> 9) & 1) << 5); R = (st >> 1) * 16 + swz / 64; C = (st & 1) * 32 + (swz % 64) / 2; }
__host__ __device__ __forceinline__ int perm32(int rho) { const int n = rho >> 4, i = rho & 15; return 8 * (i >> 2) + 4 * n + (i & 3); }

struct Unit { int pm, pn; };

struct StaticOrder {
    int nM, nN, nwg, G, c;
    __host__ __device__ void init(int M, int N, int G_, int c_) { nM = M / BM; nN = N / BM; nwg = nM * nN; G = G_; c = c_; }
    __host__ __device__ bool next(int i, Unit& u) const {
        const long L = (long)i * G + c; if (L >= nwg) return false;
        int wgid = (int)L; { const int q = nwg / NXCD, r = nwg % NXCD, xcd = wgid % NXCD, off = wgid / NXCD; wgid = (xcd < r ? xcd * (q + 1) : r * (q + 1) + (xcd - r) * q) + off; }
        const int nig = WGM * nN, gid = wgid / nig, fm = gid * WGM, gsz = (nM - fm) < WGM ? (nM - fm) : WGM;
        u.pm = fm + ((wgid % nig) % gsz); u.pn = (wgid % nig) / gsz; return true;
    }
    __device__ __forceinline__ void a_ready(const Unit&) const {}
    __device__ __forceinline__ void done(const Unit&) const {}
};

struct Gemm { const bf16_t* A; const bf16_t* Bt; int M, N, K, lda; };
__device__ __forceinline__ unsigned cvt_pk_bf16(float lo, float hi) { unsigned r; asm volatile("v_cvt_pk_bf16_f32 %0, %1, %2" : "=v"(r) : "v"(lo), "v"(hi)); return r; }

struct EpiStore {
    static constexpr bool PERM = true, AFTER_DRAIN = false;
    bf16_t* O; int ldc;
    __device__ __forceinline__ void operator()(const f32x4 (&acc)[2][2][4][2], const Unit& u, int wr, int wc, int fr, int fq) const {
        const int row0 = u.pm * BM + wr * 64 + fr; const int col0 = u.pn * BM + wc * 32 + 8 * fq;
#pragma unroll
        for (int ai = 0; ai < 2; ++ai)
#pragma unroll
            for (int m = 0; m < 4; ++m) { bf16_t* rowp = O + (size_t)(row0 + ai * HALF + m * 16) * ldc + col0;
#pragma unroll
                for (int bj = 0; bj < 2; ++bj) { const f32x4 v0 = acc[ai][bj][m][0], v1 = acc[ai][bj][m][1];
                    u32x4 w; w.x = cvt_pk_bf16(v0[0], v0[1]); w.y = cvt_pk_bf16(v0[2], v0[3]); w.z = cvt_pk_bf16(v1[0], v1[1]); w.w = cvt_pk_bf16(v1[2], v1[3]);
                    *(u32x4*)(rowp + bj * HALF) = w; } }
    }
};
template <int CTRL> __device__ __forceinline__ float row_shr_fill1(float v) { return __int_as_float(__builtin_amdgcn_update_dpp(0x3f800000, __float_as_int(v), CTRL, 0xf, 0xf, false)); }
struct EpiProj {
    static constexpr bool PERM = true, AFTER_DRAIN = false;
    bf16_t* O; int ldc; const float* rope;
    bf16_t* QTg; bf16_t* KHg; bf16_t* KTg; float* EBg; const float* lb;
    __device__ __forceinline__ void hgrn(const f32x4 (&acc)[2][2][4][2], const Unit& u, int wr, int wc, int fr, int fq) const {
        const int h = u.pn, kb = h * 128 + wc * 32 + 8 * fq, lane = fq * 16 + fr;
        const f32x4 lb0 = *(const f32x4*)(lb + kb), lb1 = *(const f32x4*)(lb + kb + 4);
#pragma unroll
        for (int ai = 0; ai < 2; ++ai)
#pragma unroll
            for (int m = 0; m < 4; ++m) { const int row = u.pm * BM + ai * HALF + wr * 64 + m * 16 + fr, chunk = row >> 4;
                float qt[8], kh[8], kt[8], el[8];
#pragma unroll
                for (int n = 0; n < 2; ++n)
#pragma unroll
                    for (int i = 0; i < 4; ++i) { const int ix = 4 * n + i; const float q = acc[ai][0][m][n][i]; float fl = acc[ai][1][m][n][i]; const float lbk = n ? lb1[i] : lb0[i];
                        fl = fminf(fmaxf(fl, -30.f), 30.f);
                        const float e = __expf(-fl), sg = __builtin_amdgcn_rcpf(1.f + e), oml = 1.f - lbk, f = lbk + oml * sg, kk = oml * e * sg;
                        float E = f;
                        E *= row_shr_fill1<0x111>(E); E *= row_shr_fill1<0x112>(E); E *= row_shr_fill1<0x114>(E); E *= row_shr_fill1<0x118>(E);
                        const float El = __shfl(E, (lane & 48) | 15);
                        const float qh = q * __builtin_amdgcn_rcpf(1.f + __expf(-q));
                        const float iE = __builtin_amdgcn_rcpf(E);
                        qt[ix] = qh * E; kh[ix] = kk * iE; kt[ix] = kh[ix] * El; el[ix] = El; }
                u32x4 w; w.x = cvt_pk_bf16(qt[0], qt[1]); w.y = cvt_pk_bf16(qt[2], qt[3]); w.z = cvt_pk_bf16(qt[4], qt[5]); w.w = cvt_pk_bf16(qt[6], qt[7]);
                *(u32x4*)(QTg + (size_t)row * 512 + kb) = w;
                w.x = cvt_pk_bf16(kh[0], kh[1]); w.y = cvt_pk_bf16(kh[2], kh[3]); w.z = cvt_pk_bf16(kh[4], kh[5]); w.w = cvt_pk_bf16(kh[6], kh[7]);
                *(u32x4*)(KHg + (size_t)row * 512 + kb) = w;
                bf16_t* ktp = KTg + ((size_t)chunk * 512 + kb) * 16 + fr;
#pragma unroll
                for (int ix = 0; ix < 8; ix += 2) { const unsigned pr = cvt_pk_bf16(kt[ix], kt[ix + 1]); ktp[ix * 16] = (bf16_t)(pr & 0xffffu); ktp[(ix + 1) * 16] = (bf16_t)(pr >> 16); }
                if (fr == 0) { float* ep = EBg + (size_t)chunk * 512 + kb; *(f32x4*)ep = (f32x4){el[0], el[1], el[2], el[3]}; *(f32x4*)(ep + 4) = (f32x4){el[4], el[5], el[6], el[7]}; }
            }
    }
    __device__ __forceinline__ void operator()(const f32x4 (&acc)[2][2][4][2], const Unit& u, int wr, int wc, int fr, int fq) const {
        if (u.pn < 4) { hgrn(acc, u, wr, wc, fr, fq); return; }
        const int row0 = u.pm * BM + wr * 64 + fr; const int col0 = u.pn * BM + wc * 32 + 8 * fq;
        bool rp[2];
#pragma unroll
        for (int bj = 0; bj < 2; ++bj) { const int cb = u.pn * BM + bj * HALF; rp[bj] = (wc == 0) && ((cb >= 2048 && cb < 3584) || (cb >= 4352 && cb < 5376)); }
        const bool anyr = rp[0] || rp[1];
        const float sgn = (fq < 2) ? -1.f : 1.f;
#pragma unroll
        for (int ai = 0; ai < 2; ++ai)
#pragma unroll
            for (int m = 0; m < 4; ++m) { const int row = row0 + ai * HALF + m * 16; bf16_t* rowp = O + (size_t)row * ldc + col0;
                f32x4 c0 = {1.f, 1.f, 1.f, 1.f}, c1 = c0, s0 = {0.f, 0.f, 0.f, 0.f}, s1 = s0;
                if (anyr) { const float* rt = rope + (size_t)(row & 2047) * 32 + 8 * (fq & 1);
                    c0 = *(const f32x4*)(rt); c1 = *(const f32x4*)(rt + 4); s0 = *(const f32x4*)(rt + 16); s1 = *(const f32x4*)(rt + 20); }
#pragma unroll
                for (int bj = 0; bj < 2; ++bj) { f32x4 v0 = acc[ai][bj][m][0], v1 = acc[ai][bj][m][1];
                    if (rp[bj]) {
                        f32x4 p0, p1;
#pragma unroll
                        for (int i = 0; i < 4; ++i) { p0[i] = __shfl_xor(v0[i], 32); p1[i] = __shfl_xor(v1[i], 32); }
                        v0 = v0 * c0 + (p0 * s0) * sgn; v1 = v1 * c1 + (p1 * s1) * sgn;
                    }
                    u32x4 w; w.x = cvt_pk_bf16(v0[0], v0[1]); w.y = cvt_pk_bf16(v0[2], v0[3]); w.z = cvt_pk_bf16(v1[0], v1[1]); w.w = cvt_pk_bf16(v1[2], v1[3]);
                    *(u32x4*)(rowp + bj * HALF) = w; } }
    }
};
struct EpiZ {
    static constexpr bool PERM = false, AFTER_DRAIN = false;
    const float* res; float* Z; float alpha;
    __device__ __forceinline__ void operator()(const f32x4 (&acc)[2][2][4][2], const Unit& u, int wr, int wc, int fr, int fq) const {
        const int col0 = u.pn * BM + wc * 32 + 4 * fq;
#pragma unroll
        for (int ai = 0; ai < 2; ++ai)
#pragma unroll
            for (int m = 0; m < 4; ++m) { const int r = u.pm * BM + ai * HALF + wr * 64 + m * 16 + fr; const size_t off = (size_t)r * 2048 + col0;
#pragma unroll
                for (int bj = 0; bj < 2; ++bj)
#pragma unroll
                    for (int n = 0; n < 2; ++n) { const f32x4 bs = *(const f32x4*)(res + off + bj * HALF + n * 16); const f32x4 o = bs * alpha + acc[ai][bj][m][n]; *(f32x4*)(Z + off + bj * HALF + n * 16) = o; } }
    }
};
template <class Epi, class Sched, bool ALIGN_EPI = false, bool SP2 = false>
__device__ __forceinline__ void gemm_phase(PG8_LAS unsigned char* lds, const Gemm g, const Sched& S, const Epi& E) {
    int tid_ = threadIdx.x; asm volatile("" : "+v"(tid_));
    const int tid = tid_, wid = __builtin_amdgcn_readfirstlane(tid >> 6), lane = tid & 63, wr = wid >> 2, wc = wid & 3, fr = lane & 15, fq = lane >> 4;
    const int K = g.K, nt = K / BK, lda = g.lda;
    unsigned voffA[2], voffB[2];
#pragma unroll
    for (int i = 0; i < 2; ++i) { int R, C; stage_rc(tid * 16 + i * 8192, R, C); const int Rb = Epi::PERM ? ((R & ~31) + perm32(R & 31)) : R;
        voffA[i] = (unsigned)(R * lda + C) * 2u; voffB[i] = (unsigned)(Rb * K + C) * 2u; }
    const size_t kstep = (size_t)(BK * 2);
    const size_t hstep = (size_t)HALF * K * 2;
    const size_t tstep = 2 * hstep; const size_t hstepA = (size_t)HALF * lda * 2, tstepA = 2 * hstepA;
    const unsigned ldsw = (unsigned)wid * 1024u;
    const int aoff = lds_byte(wr * 64 + fr, fq * 8), boff = lds_byte(wc * 32 + fr, fq * 8);
#define PG8_SA(b, h) (((b) * 2 + (h)) * HTB)
#define PG8_SB(b, h) ((4 + (b) * 2 + (h)) * HTB)
#define PG8_STAGE(bufoff, gbase, voff) do { _Pragma("unroll") for (int _i = 0; _i < 2; ++_i) \
        __builtin_amdgcn_global_load_lds((const unsigned*)((const char*)(gbase) + (voff)[_i]), (PG8_LAS unsigned*)(lds + (bufoff) + ldsw + _i * 8192), 16, 0, 0); } while (0)
#define PG8_LDA(dst, b, h) do { _Pragma("unroll") for (int m = 0; m < 4; ++m) _Pragma("unroll") for (int k = 0; k < 2; ++k) dst[m][k] = *(const PG8_LAS bf16x8*)(lds + PG8_SA(b, h) + aoff + m * 2048 + k * 1024); } while (0)
#define PG8_LDB(dst, b, h) do { _Pragma("unroll") for (int n = 0; n < 2; ++n) _Pragma("unroll") for (int k = 0; k < 2; ++k) dst[n][k] = *(const PG8_LAS bf16x8*)(lds + PG8_SB(b, h) + boff + n * 2048 + k * 1024); } while (0)
#define PG8_MMA(ai, bj, At, Bt) do { __builtin_amdgcn_s_setprio(1); _Pragma("unroll") for (int m = 0; m < 4; ++m) _Pragma("unroll") for (int n = 0; n < 2; ++n) _Pragma("unroll") for (int k = 0; k < 2; ++k) \
        acc[ai][bj][m][n] = __builtin_amdgcn_mfma_f32_16x16x32_bf16(Bt[n][k], At[m][k], acc[ai][bj][m][n], 0, 0, 0); __builtin_amdgcn_s_setprio(0); } while (0)
#define PG8_WAIT_V(n) asm volatile("s_waitcnt vmcnt(" #n ")" ::: "memory")
#define PG8_WAIT_L(n) asm volatile("s_waitcnt lgkmcnt(" #n ")" ::: "memory")
#define PG8_BAR __builtin_amdgcn_s_barrier()
#define PG8_SCHED __builtin_amdgcn_sched_barrier(0)
    Unit cur, nxt; int ui = 0;
    if (!S.next(0, cur)) return;
    f32x4 acc[2][2][4][2];
#pragma unroll
    for (int a = 0; a < 2; ++a)
#pragma unroll
        for (int b = 0; b < 2; ++b)
#pragma unroll
            for (int m = 0; m < 4; ++m)
#pragma unroll
                for (int n = 0; n < 2; ++n) acc[a][b][m][n] = (f32x4){0.f, 0.f, 0.f, 0.f};
    bf16x8 At[4][2], B0[2][2], B1[2][2];
    const char* cA = (const char*)g.A + (size_t)cur.pm * tstepA; const char* cB = (const char*)g.Bt + (size_t)cur.pn * tstep;
    S.a_ready(cur);
    if constexpr (SP2) {
        PG8_STAGE(PG8_SB(0, 0), cB, voffB); PG8_STAGE(PG8_SB(0, 1), cB + hstep, voffB); PG8_STAGE(PG8_SA(0, 0), cA, voffA); PG8_STAGE(PG8_SA(0, 1), cA + hstepA, voffA);
        if (wr == 1) PG8_BAR;
        PG8_WAIT_V(2); PG8_BAR;
        PG8_STAGE(PG8_SB(1, 0), cB + kstep, voffB); PG8_STAGE(PG8_SA(1, 0), cA + kstep, voffA); PG8_STAGE(PG8_SB(1, 1), cB + hstep + kstep, voffB);
        PG8_WAIT_V(6); PG8_BAR;
    } else {
        PG8_STAGE(PG8_SB(0, 0), cB, voffB); PG8_STAGE(PG8_SA(0, 0), cA, voffA); PG8_STAGE(PG8_SB(0, 1), cB + hstep, voffB); PG8_STAGE(PG8_SA(0, 1), cA + hstepA, voffA);
        if (wr == 1) PG8_BAR;
        PG8_WAIT_V(4); PG8_BAR;
        PG8_STAGE(PG8_SB(1, 0), cB + kstep, voffB); PG8_STAGE(PG8_SA(1, 0), cA + kstep, voffA); PG8_STAGE(PG8_SB(1, 1), cB + hstep + kstep, voffB);
        PG8_WAIT_V(6); PG8_BAR;
    }
    for (;;) {
        const bool has_next = S.next(ui + 1, nxt);
        const char* nA = has_next ? (const char*)g.A + (size_t)nxt.pm * tstepA : cA; const char* nB = has_next ? (const char*)g.Bt + (size_t)nxt.pn * tstep : cB;
        for (int t = 0; t < nt; t += 2) {
            const bool last = (t == nt - 2);
            const char* a1 = cA + (size_t)(t + 1) * kstep;
            const char* a2 = last ? nA : cA + (size_t)(t + 2) * kstep; const char* b2 = last ? nB : cB + (size_t)(t + 2) * kstep;
            const char* a3 = a2 + kstep; const char* b3 = b2 + kstep;
            if (last && has_next) S.a_ready(nxt);
            if constexpr (SP2) {
            PG8_LDB(B0, 0, 0); PG8_LDB(B1, 0, 1); PG8_SCHED; PG8_LDA(At, 0, 0); PG8_STAGE(PG8_SA(1, 1), a1 + hstepA, voffA);
            PG8_WAIT_V(8); PG8_WAIT_L(0); PG8_BAR; PG8_MMA(0, 0, At, B0); PG8_MMA(0, 1, At, B1); PG8_BAR; PG8_SCHED;
            PG8_LDA(At, 0, 1); PG8_STAGE(PG8_SB(0, 0), b2, voffB); PG8_STAGE(PG8_SB(0, 1), b2 + hstep, voffB); PG8_STAGE(PG8_SA(0, 0), a2, voffA);
            PG8_WAIT_V(8); PG8_WAIT_L(0); PG8_BAR; PG8_MMA(1, 0, At, B0); PG8_MMA(1, 1, At, B1); PG8_BAR; PG8_SCHED;
            PG8_LDB(B0, 1, 0); PG8_LDB(B1, 1, 1); PG8_SCHED; PG8_LDA(At, 1, 0); PG8_STAGE(PG8_SA(0, 1), a2 + hstepA, voffA);
            PG8_WAIT_V(8); PG8_WAIT_L(0); PG8_BAR; PG8_MMA(0, 0, At, B0); PG8_MMA(0, 1, At, B1); PG8_BAR; PG8_SCHED;
            PG8_LDA(At, 1, 1); PG8_STAGE(PG8_SB(1, 0), b3, voffB); PG8_STAGE(PG8_SB(1, 1), b3 + hstep, voffB); PG8_STAGE(PG8_SA(1, 0), a3, voffA);
            PG8_WAIT_V(8); PG8_WAIT_L(0); PG8_BAR; PG8_MMA(1, 0, At, B0); PG8_MMA(1, 1, At, B1); PG8_BAR; PG8_SCHED;
            } else {
            PG8_LDB(B0, 0, 0); PG8_SCHED; PG8_LDA(At, 0, 0); PG8_STAGE(PG8_SA(1, 1), a1 + hstepA, voffA);
            PG8_WAIT_L(8); PG8_BAR; PG8_WAIT_L(0); PG8_MMA(0, 0, At, B0); PG8_BAR; PG8_SCHED;
            PG8_LDB(B1, 0, 1); PG8_STAGE(PG8_SB(0, 0), b2, voffB);
            PG8_BAR; PG8_WAIT_L(0); PG8_MMA(0, 1, At, B1); PG8_BAR;
            PG8_LDA(At, 0, 1); PG8_STAGE(PG8_SA(0, 0), a2, voffA);
            PG8_BAR; PG8_WAIT_L(0); PG8_MMA(1, 0, At, B0); PG8_BAR; PG8_SCHED;
            PG8_STAGE(PG8_SB(0, 1), b2 + hstep, voffB);
            PG8_WAIT_V(6); PG8_BAR; PG8_MMA(1, 1, At, B1); PG8_BAR;
            PG8_LDB(B0, 1, 0); PG8_SCHED; PG8_LDA(At, 1, 0); PG8_STAGE(PG8_SA(0, 1), a2 + hstepA, voffA);
            PG8_WAIT_L(8); PG8_BAR; PG8_WAIT_L(0); PG8_MMA(0, 0, At, B0); PG8_BAR; PG8_SCHED;
            PG8_LDB(B1, 1, 1); PG8_STAGE(PG8_SB(1, 0), b3, voffB);
            PG8_BAR; PG8_WAIT_L(0); PG8_MMA(0, 1, At, B1); PG8_BAR;
            PG8_LDA(At, 1, 1); PG8_STAGE(PG8_SA(1, 0), a3, voffA);
            PG8_BAR; PG8_WAIT_L(0); PG8_MMA(1, 0, At, B0); PG8_BAR; PG8_SCHED;
            PG8_STAGE(PG8_SB(1, 1), b3 + hstep, voffB);
            PG8_WAIT_V(6); PG8_BAR; PG8_MMA(1, 1, At, B1); PG8_BAR;
            }
        }
        if constexpr (ALIGN_EPI) { if (wr == 0) PG8_BAR; }
        if constexpr (!Epi::AFTER_DRAIN) { E(acc, cur, wr, wc, fr, fq); S.done(cur); }
        if (!has_next) break;
#pragma unroll
        for (int a = 0; a < 2; ++a)
#pragma unroll
            for (int b = 0; b < 2; ++b)
#pragma unroll
                for (int m = 0; m < 4; ++m)
#pragma unroll
                    for (int n = 0; n < 2; ++n) acc[a][b][m][n] = (f32x4){0.f, 0.f, 0.f, 0.f};
        cur = nxt; cA = nA; cB = nB; ++ui;
        if constexpr (ALIGN_EPI) { if (wr == 1) PG8_BAR; }
    }
    PG8_WAIT_V(0);
    if constexpr (!ALIGN_EPI) { if (wr == 0) PG8_BAR; }
    PG8_BAR;
    if constexpr (Epi::AFTER_DRAIN) { E.fused(acc, cur, wr, wc, fr, fq, lds, wid, lane); S.done(cur); }
#undef PG8_SA
#undef PG8_SB
#undef PG8_STAGE
#undef PG8_LDA
#undef PG8_LDB
#undef PG8_MMA
#undef PG8_WAIT_V
#undef PG8_WAIT_L
#undef PG8_BAR
#undef PG8_SCHED
}
}
#define LAS __attribute__((address_space(3)))
typedef unsigned short bf16_t;
typedef short bf16x8 __attribute__((ext_vector_type(8)));
typedef short bf16x4 __attribute__((ext_vector_type(4)));
typedef float f32x4 __attribute__((ext_vector_type(4)));
typedef unsigned u32x4 __attribute__((ext_vector_type(4)));
typedef unsigned u32x2 __attribute__((ext_vector_type(2)));
constexpr int M_TOK = 8192, SEQ = 2048, DM = 2048, INW = 5632, FF = 5632, GUW = 11264;
constexpr float ALPHA = 1.4142135623730951f, LN_EPS = 1e-5f;
constexpr size_t MiB = 1u << 20;
constexpr size_t WS_ROPE = 64 * 1024, WS_LBS = 320 * 1024;
constexpr size_t WS_WIN = 1 * MiB, WS_WOUT = 23 * MiB, WS_WGU = 31 * MiB, WS_WDN = 75 * MiB;
constexpr size_t WS_XB = 97 * MiB, WS_XRES = 129 * MiB, WS_R = 193 * MiB;
constexpr size_t WS_PROJ = WS_R, WS_MIXED = WS_R + 88 * MiB, WS_OBP = WS_R + 120 * MiB, WS_OA = WS_R + 156 * MiB, WS_LSE = WS_R + 172 * MiB;
constexpr size_t WS_GU = WS_R;
constexpr size_t WS_QT = WS_R + 173 * MiB, WS_KH = WS_R + 181 * MiB, WS_KT = WS_R + 189 * MiB, WS_EB = WS_R + 197 * MiB;
constexpr size_t WS_END = 448 * MiB;
constexpr int LDS_BYTES = 141312 + 1024;
constexpr int NWAVES = 8, NTHR = 512;

__device__ __forceinline__ float bf2f(unsigned short v) { return __uint_as_float((unsigned)v << 16); }
__device__ __forceinline__ unsigned f2bf(float f) { unsigned u = __float_as_uint(f); return (u + 0x7fffu + ((u >> 16) & 1u)) >> 16; }
__device__ __forceinline__ unsigned pk2(float lo, float hi) { return pg8::cvt_pk_bf16(lo, hi); }
__device__ __forceinline__ float wave_sum(float v) {
#pragma unroll
    for (int o = 1; o < 64; o <<= 1) v += __shfl_xor(v, o);
    return v;
}
#define LDS_WAIT() asm volatile("s_waitcnt lgkmcnt(0)" ::: "memory")

__device__ __forceinline__ void transpose_item(const float* W, int K, int N, bf16_t* WT, int k0, int n0, int new_n0, int lane) {
    typedef float f32x2 __attribute__((ext_vector_type(2)));
    const float* src = W + (size_t)k0 * N + n0 + 2 * lane;
    bf16_t* d0 = WT + (size_t)(new_n0 + 2 * lane) * K + k0; bf16_t* d1 = d0 + K;
#pragma unroll
    for (int hb = 0; hb < 2; ++hb) {
        f32x2 v[32];
#pragma unroll
        for (int i = 0; i < 32; ++i) v[i] = __builtin_nontemporal_load((const f32x2*)(src + (size_t)(32 * hb + i) * N));
#pragma unroll
        for (int q = 0; q < 4; ++q) { u32x4 a, c;
            a.x = pk2(v[8 * q][0], v[8 * q + 1][0]); a.y = pk2(v[8 * q + 2][0], v[8 * q + 3][0]); a.z = pk2(v[8 * q + 4][0], v[8 * q + 5][0]); a.w = pk2(v[8 * q + 6][0], v[8 * q + 7][0]);
            c.x = pk2(v[8 * q][1], v[8 * q + 1][1]); c.y = pk2(v[8 * q + 2][1], v[8 * q + 3][1]); c.z = pk2(v[8 * q + 4][1], v[8 * q + 5][1]); c.w = pk2(v[8 * q + 6][1], v[8 * q + 7][1]);
            *(u32x4*)(d0 + 32 * hb + 8 * q) = a; *(u32x4*)(d1 + 32 * hb + 8 * q) = c; }
    }
}

struct Ptrs {
    const float* in[15]; float* out; unsigned char* ws;
};

__device__ __forceinline__ void convert_weights(const Ptrs& P, int l, int gw, int NGW, int lane) {
    constexpr int I_IN = 32 * 44, I_OUT = 32 * 16, I_G = 32 * 44, I_D = 88 * 16;
    constexpr int NITEMS = I_IN + I_OUT + 2 * I_G + I_D;
    bf16_t* Win_t = (bf16_t*)(P.ws + WS_WIN); bf16_t* Wout_t = (bf16_t*)(P.ws + WS_WOUT); bf16_t* Wgu_t = (bf16_t*)(P.ws + WS_WGU); bf16_t* Wdn_t = (bf16_t*)(P.ws + WS_WDN);
    const float* w_in = P.in[1] + (size_t)l * DM * INW; const float* w_out = P.in[5] + (size_t)l * DM * DM;
    const float* w_gate = P.in[8] + (size_t)l * DM * FF; const float* w_up = P.in[9] + (size_t)l * DM * FF; const float* w_down = P.in[12] + (size_t)l * FF * DM;
    for (int it = gw; it < NITEMS; it += NGW) {
        int r = it;
        if (r < I_IN) { const int kb = r / 44, nb = r % 44, n0 = 128 * nb; const int nn = (nb < 8) ? ((nb & 3) * 256 + (nb >> 2) * 128) : n0;
            transpose_item(w_in, DM, INW, Win_t, 64 * kb, n0, nn, lane); continue; } r -= I_IN;
        if (r < I_OUT) { transpose_item(w_out, DM, DM, Wout_t, 64 * (r / 16), 128 * (r % 16), 128 * (r % 16), lane); continue; } r -= I_OUT;
        if (r < I_G) { transpose_item(w_gate, DM, FF, Wgu_t, 64 * (r / 44), 128 * (r % 44), 128 * (r % 44), lane); continue; } r -= I_G;
        if (r < I_G) { transpose_item(w_up, DM, FF, Wgu_t, 64 * (r / 44), 128 * (r % 44), FF + 128 * (r % 44), lane); continue; } r -= I_G;
        transpose_item(w_down, FF, DM, Wdn_t, 64 * (r / 16), 128 * (r % 16), 128 * (r % 16), lane);
    }
}

__device__ __forceinline__ void ln_row(const float* zrow, const float* gam, const float* bet, float* out_f, bf16_t* out_b, int lane) {
    f32x4 v[8]; float s = 0.f;
#pragma unroll
    for (int j = 0; j < 8; ++j) { v[j] = *(const f32x4*)(zrow + 4 * lane + 256 * j); s += (v[j][0] + v[j][1]) + (v[j][2] + v[j][3]); }
    const float mean = wave_sum(s) * (1.f / 2048.f); float s2 = 0.f;
#pragma unroll
    for (int j = 0; j < 8; ++j) { v[j] = v[j] - mean; s2 += (v[j][0] * v[j][0] + v[j][1] * v[j][1]) + (v[j][2] * v[j][2] + v[j][3] * v[j][3]); }
    const float rstd = 1.f / sqrtf(wave_sum(s2) * (1.f / 2048.f) + LN_EPS);
#pragma unroll
    for (int j = 0; j < 8; ++j) { const f32x4 gg = *(const f32x4*)(gam + 4 * lane + 256 * j), bb = *(const f32x4*)(bet + 4 * lane + 256 * j);
        const f32x4 o = v[j] * rstd * gg + bb;
        if (out_f) *(f32x4*)(out_f + 4 * lane + 256 * j) = o;
        if (out_b) { u32x2 w; w.x = pk2(o[0], o[1]); w.y = pk2(o[2], o[3]); *(u32x2*)(out_b + 4 * lane + 256 * j) = w; } }
}

__device__ __forceinline__ void attn_item(LAS unsigned char* lds, const bf16_t* proj, int b, int qcol, int kcol, int vcol, int dil, int res, int nb, int maxlag,
                                          bool hasSink, float sink, bf16_t* out, int ldo, int ocol, float* lsep, int tid, int wid, int lane) {
    constexpr int KROW = 272, VROW = 528;
    LAS unsigned char* Ks = lds; LAS unsigned char* Vs = lds + 256 * KROW;
    const int tk0 = (nb - 1) * 128;
#pragma unroll
    for (int i = 0; i < 8; ++i) { const int e = tid + 512 * i, key = e >> 4, ch = e & 15, tau = tk0 + key;
        u32x4 v = {0u, 0u, 0u, 0u};
        if (tau >= 0) v = *(const u32x4*)(proj + (size_t)(b * SEQ + tau * dil + res) * INW + kcol + ch * 8);
        *(LAS u32x4*)(Ks + key * KROW + ch * 16) = v; }
#pragma unroll
    for (int i = 0; i < 4; ++i) { const int e = tid + 512 * i, ch = (e & 1) | (((e >> 6) & 7) << 1), kp = ((e >> 1) & 31) | ((e >> 9) << 5), tau0 = tk0 + 2 * kp;
        u32x4 a = {0u, 0u, 0u, 0u}, c = {0u, 0u, 0u, 0u};
        if (tau0 >= 0) { a = *(const u32x4*)(proj + (size_t)(b * SEQ + tau0 * dil + res) * INW + vcol + ch * 8); c = *(const u32x4*)(proj + (size_t)(b * SEQ + (tau0 + 1) * dil + res) * INW + vcol + ch * 8); }
#pragma unroll
        for (int q = 0; q < 4; ++q) {
            *(LAS unsigned*)(Vs + (ch * 8 + 2 * q) * VROW + kp * 4) = (a[q] & 0xffffu) | (c[q] << 16);
            *(LAS unsigned*)(Vs + (ch * 8 + 2 * q + 1) * VROW + kp * 4) = (a[q] >> 16) | (c[q] & 0xffff0000u); } }
    __syncthreads();
    const int l15 = lane & 15, g = lane >> 4;
    const int r = 16 * wid + l15, tq = (nb * 128 + r) * dil + res; const size_t qrow = (size_t)b * SEQ + tq;
    bf16x8 Qf[4];
#pragma unroll
    for (int kk = 0; kk < 4; ++kk) Qf[kk] = *(const bf16x8*)(proj + qrow * INW + qcol + 32 * kk + 8 * g);
    f32x4 S[10];
#pragma unroll
    for (int i = 0; i < 10; ++i) { const int kt = wid + i, ktc = kt < 15 ? kt : 15; f32x4 acc = {0.f, 0.f, 0.f, 0.f};
#pragma unroll
        for (int kk = 0; kk < 4; ++kk) { const bf16x8 A = *(const LAS bf16x8*)(Ks + (16 * ktc + l15) * KROW + (32 * kk + 8 * g) * 2); acc = __builtin_amdgcn_mfma_f32_16x16x32_bf16(A, Qf[kk], acc, 0, 0, 0); }
        S[i] = acc; }
    const float scale = 0.08838834764831845f;
    float mx = -1e30f;
#pragma unroll
    for (int i = 0; i < 10; ++i)
#pragma unroll
        for (int j = 0; j < 4; ++j) { const int c = 16 * (wid + i) + 4 * g + j, lag = 128 + r - c; const bool valid = (wid + i < 16) && lag >= 0 && lag <= maxlag && (tk0 + c >= 0);
            const float s = valid ? S[i][j] * scale : -1e30f; S[i][j] = s; mx = fmaxf(mx, s); }
    mx = fmaxf(mx, __shfl_xor(mx, 16)); mx = fmaxf(mx, __shfl_xor(mx, 32));
    if (hasSink) mx = fmaxf(mx, sink);
    float sum = 0.f;
#pragma unroll
    for (int i = 0; i < 10; ++i)
#pragma unroll
        for (int j = 0; j < 4; ++j) { const float p = __expf(S[i][j] - mx); S[i][j] = p; sum += p; }
    sum += __shfl_xor(sum, 16); sum += __shfl_xor(sum, 32);
    if (hasSink) sum += __expf(sink - mx);
    bf16x8 Pf[5];
#pragma unroll
    for (int sl = 0; sl < 5; ++sl) { u32x4 w; w.x = pk2(S[2 * sl][0], S[2 * sl][1]); w.y = pk2(S[2 * sl][2], S[2 * sl][3]); w.z = pk2(S[2 * sl + 1][0], S[2 * sl + 1][1]); w.w = pk2(S[2 * sl + 1][2], S[2 * sl + 1][3]); Pf[sl] = __builtin_bit_cast(bf16x8, w); }
    const float inv = 1.f / sum;
#pragma unroll
    for (int dt = 0; dt < 8; ++dt) { f32x4 acc = {0.f, 0.f, 0.f, 0.f}; const int d = 16 * dt + l15;
#pragma unroll
        for (int sl = 0; sl < 5; ++sl) { const int k0 = (wid + 2 * sl) < 15 ? (wid + 2 * sl) : 15, k1 = (wid + 2 * sl + 1) < 15 ? (wid + 2 * sl + 1) : 15;
            const u32x2 lo = *(const LAS u32x2*)(Vs + d * VROW + (16 * k0 + 4 * g) * 2), hi = *(const LAS u32x2*)(Vs + d * VROW + (16 * k1 + 4 * g) * 2);
            u32x4 w; w.x = lo.x; w.y = lo.y; w.z = hi.x; w.w = hi.y;
            acc = __builtin_amdgcn_mfma_f32_16x16x32_bf16(__builtin_bit_cast(bf16x8, w), Pf[sl], acc, 0, 0, 0); }
        acc = acc * inv; u32x2 w; w.x = pk2(acc[0], acc[1]); w.y = pk2(acc[2], acc[3]);
        *(u32x2*)(out + qrow * ldo + ocol + 16 * dt + 4 * g) = w; }
    if (lsep && g == 0) lsep[qrow * 6] = mx + __logf(sum);
    __syncthreads();
}

constexpr int HG_QT = 0, HG_KH = 17408, HG_V = 34816, HG_KT = 52224, HG_EB = 68608, HG_BUF = 70656;
struct HgRegs { u32x4 q[2], k[2], v[2], t[2], e; };
__device__ __forceinline__ void hgrn_load(HgRegs& R, const bf16_t* QTg, const bf16_t* KHg, const bf16_t* KTg, const float* EBg, const bf16_t* proj, int b, int h, int r, int tid) {
    const size_t row0 = (size_t)b * SEQ + 64 * r; const size_t c0 = row0 >> 4;
#pragma unroll
    for (int i = 0; i < 2; ++i) { const int e = tid + 512 * i, row = e >> 4, ch = e & 15;
        R.q[i] = *(const u32x4*)(QTg + (row0 + row) * 512 + h * 128 + ch * 8);
        R.k[i] = *(const u32x4*)(KHg + (row0 + row) * 512 + h * 128 + ch * 8);
        R.v[i] = *(const u32x4*)(proj + (row0 + row) * INW + 1024 + h * 128 + ch * 8);
        const int chk = e >> 8, wi = e & 255;
        R.t[i] = *(const u32x4*)(KTg + ((c0 + chk) * 512 + h * 128) * 16 + wi * 8); }
    { const int t7 = tid & 127, chk = t7 >> 5, wi = t7 & 31; R.e = *(const u32x4*)(EBg + (c0 + chk) * 512 + h * 128 + wi * 4); }
}
__device__ __forceinline__ void hgrn_store(const HgRegs& R, LAS unsigned char* base, int tid) {
#pragma unroll
    for (int i = 0; i < 2; ++i) { const int e = tid + 512 * i, row = e >> 4, ch = e & 15;
        *(LAS u32x4*)(base + HG_QT + row * 272 + ch * 16) = R.q[i];
        *(LAS u32x4*)(base + HG_KH + row * 272 + ch * 16) = R.k[i];
        *(LAS u32x4*)(base + HG_V + row * 272 + ch * 16) = R.v[i];
        *(LAS u32x4*)(base + HG_KT + e * 16) = R.t[i]; }
    *(LAS u32x4*)(base + HG_EB + (tid & 127) * 16) = R.e;
}
__device__ __forceinline__ void hgrn_flush(const f32x4 (&ov)[4], float* oA, int b, int h, int r, int voff, int lane) {
    const int l15 = lane & 15, g = lane >> 4;
#pragma unroll
    for (int ch = 0; ch < 4; ++ch) { float* op = oA + (size_t)(b * SEQ + 64 * r + 16 * ch + 4 * g) * 512 + h * 128 + voff + l15;
#pragma unroll
        for (int j = 0; j < 4; ++j) op[(size_t)j * 512] = ov[ch][j]; }
}
__device__ __forceinline__ void hgrn_compute(LAS unsigned char* base, f32x4 (&S)[8], f32x4 (&ov)[4], int voff, int lane) {
    const int l15 = lane & 15, g = lane >> 4;
    bf16x4 Vf[4]; f32x4 o[4];
#pragma unroll
    for (int ch = 0; ch < 4; ++ch) {
        bf16x8 Kf[4], Qf[4];
#pragma unroll
        for (int p = 0; p < 4; ++p) { const int off = ((16 * ch + l15) * 136 + 32 * p + 4 * g) * 2;
            const u32x2 a = *(const LAS u32x2*)(base + HG_QT + off), a2 = *(const LAS u32x2*)(base + HG_QT + off + 32);
            const u32x2 c = *(const LAS u32x2*)(base + HG_KH + off), c2 = *(const LAS u32x2*)(base + HG_KH + off + 32);
            u32x4 w; w.x = a.x; w.y = a.y; w.z = a2.x; w.w = a2.y; Qf[p] = __builtin_bit_cast(bf16x8, w);
            w.x = c.x; w.y = c.y; w.z = c2.x; w.w = c2.y; Kf[p] = __builtin_bit_cast(bf16x8, w); }
        const LAS bf16_t* vp = (const LAS bf16_t*)(base + HG_V + (16 * ch + 4 * g) * 272 + (voff + l15) * 2);
        u32x2 vw; vw.x = (unsigned)vp[0] | ((unsigned)vp[136] << 16); vw.y = (unsigned)vp[272] | ((unsigned)vp[408] << 16);
        Vf[ch] = __builtin_bit_cast(bf16x4, vw);
        f32x4 att = {0.f, 0.f, 0.f, 0.f};
#pragma unroll
        for (int p = 0; p < 4; ++p) att = __builtin_amdgcn_mfma_f32_16x16x32_bf16(Kf[p], Qf[p], att, 0, 0, 0);
#pragma unroll
        for (int j = 0; j < 4; ++j) att[j] = (4 * g + j <= l15) ? att[j] : 0.f;
        u32x2 aw; aw.x = pk2(att[0], att[1]); aw.y = pk2(att[2], att[3]);
        o[ch] = __builtin_amdgcn_mfma_f32_16x16x16bf16_1k(__builtin_bit_cast(bf16x4, aw), Vf[ch], (f32x4){0.f, 0.f, 0.f, 0.f}, 0, 0, 0);
        asm volatile("" ::: "memory");
    }
#pragma unroll
    for (int ch = 0; ch < 4; ++ch) {
        f32x4 eb[8]; bf16x4 Kt[8]; bf16x8 Qf[4];
#pragma unroll
        for (int p = 0; p < 4; ++p) { const int off = ((16 * ch + l15) * 136 + 32 * p + 4 * g) * 2;
            const u32x2 a = *(const LAS u32x2*)(base + HG_QT + off), a2 = *(const LAS u32x2*)(base + HG_QT + off + 32);
            u32x4 w; w.x = a.x; w.y = a.y; w.z = a2.x; w.w = a2.y; Qf[p] = __builtin_bit_cast(bf16x8, w); }
#pragma unroll
        for (int kt = 0; kt < 8; ++kt) { eb[kt] = *(const LAS f32x4*)(base + HG_EB + (ch * 128 + 16 * kt + 4 * g) * 4);
            Kt[kt] = __builtin_bit_cast(bf16x4, *(const LAS u32x2*)(base + HG_KT + (ch * 128 + 16 * kt + l15) * 32 + 8 * g)); }
        f32x4 o2 = {0.f, 0.f, 0.f, 0.f};
#pragma unroll
        for (int p = 0; p < 4; ++p) { u32x4 w; w.x = pk2(S[2 * p][0], S[2 * p][1]); w.y = pk2(S[2 * p][2], S[2 * p][3]); w.z = pk2(S[2 * p + 1][0], S[2 * p + 1][1]); w.w = pk2(S[2 * p + 1][2], S[2 * p + 1][3]);
            if (p & 1) o2 = __builtin_amdgcn_mfma_f32_16x16x32_bf16(Qf[p], __builtin_bit_cast(bf16x8, w), o2, 0, 0, 0);
            else o[ch] = __builtin_amdgcn_mfma_f32_16x16x32_bf16(Qf[p], __builtin_bit_cast(bf16x8, w), o[ch], 0, 0, 0); }
#pragma unroll
        for (int kt = 0; kt < 8; ++kt) S[kt] = __builtin_amdgcn_mfma_f32_16x16x16bf16_1k(Kt[kt], Vf[ch], S[kt] * eb[kt], 0, 0, 0);
        ov[ch] = o[ch] + o2;
        asm volatile("" ::: "memory");
    }
}
__device__ __forceinline__ void hgrn_block(LAS unsigned char* lds, const bf16_t* QTg, const bf16_t* KHg, const bf16_t* KTg, const float* EBg, const bf16_t* proj, float* oA, int b, int h, int vq, int tid, int wid, int lane) {
    f32x4 S[8];
#pragma unroll
    for (int i = 0; i < 8; ++i) S[i] = (f32x4){0.f, 0.f, 0.f, 0.f};
    const int voff = 32 * vq + 16 * wid;
    HgRegs R;
    hgrn_load(R, QTg, KHg, KTg, EBg, proj, b, h, 0, tid);
    hgrn_store(R, lds, tid);
    __syncthreads();
#pragma unroll 1
    for (int r = 0; r < 32; ++r) {
        const int rn = (r + 1 < 32) ? r + 1 : 31;
        hgrn_load(R, QTg, KHg, KTg, EBg, proj, b, h, rn, tid);
        f32x4 ov[4];
        if (wid < 2) hgrn_compute(lds + (r & 1) * HG_BUF, S, ov, voff, lane);
        asm volatile("s_waitcnt vmcnt(0)" ::: "memory");
        hgrn_store(R, lds + ((r + 1) & 1) * HG_BUF, tid);
        if (wid < 2) hgrn_flush(ov, oA, b, h, r, voff, lane);
        __syncthreads();
    }
}
typedef __attribute__((address_space(1))) unsigned gu32;
#define XB_TMO      128
#define XB_XCNT(j)  (256  + 64 * (j))
#define XB_XSUB(j)  (1280 + 64 * (j))
#define XB_XGEN(j)  (2304 + 64 * (j))
#define XB_TOP      3328
#define XB_TOPGEN   3392
#define XCD_BAR_WORDS 3456
#define XB_SPIN_CAP (1u << 18)

__device__ __forceinline__ unsigned xb_ld(unsigned* p)              { return __hip_atomic_load(p, __ATOMIC_RELAXED, __HIP_MEMORY_SCOPE_AGENT); }
__device__ __forceinline__ unsigned xb_add(unsigned* p, unsigned v) { return __hip_atomic_fetch_add(p, v, __ATOMIC_RELAXED, __HIP_MEMORY_SCOPE_AGENT); }
__device__ __forceinline__ unsigned xb_xcc_id() { return (unsigned)__builtin_amdgcn_s_getreg((3 << 11) | 20) & 0xFu; }
#define XB_SPIN(cond, bar) do { unsigned _sp = 0; while (cond) { __builtin_amdgcn_s_sleep(1); \
    if ((++_sp & 255u) == 0u) { if (xb_ld(&(bar)[XB_TMO])) break; if (_sp > XB_SPIN_CAP) { atomicAdd(&(bar)[XB_TMO], 1u); break; } } } } while (0)

struct XcdBarrier {
    unsigned* bar; unsigned x;
    volatile LAS unsigned* st;
};

__device__ __forceinline__ XcdBarrier xcd_barrier_post(unsigned* bar, volatile LAS unsigned* st) {
    XcdBarrier b; b.bar = bar; b.x = xb_xcc_id(); b.st = st;
    if (threadIdx.x == 0) (void)xb_add(&bar[XB_XCNT(b.x)], 1u);
    return b;
}
__device__ __forceinline__ void xcd_barrier_complete(unsigned* bar, unsigned x, unsigned& nloc, unsigned& nx) {
    const unsigned G = gridDim.x * gridDim.y * gridDim.z;
    unsigned sum, cnt, mine, sp = 0u;
    for (;;) {
        sum = 0u; cnt = 0u; mine = 0u;
#pragma unroll
        for (unsigned j = 0; j < 16; ++j) { const unsigned c = xb_ld(&bar[XB_XCNT(j)]); sum += c; cnt += (c > 0u) ? 1u : 0u; mine = (j == x) ? c : mine; }
        if (sum == G) break;
        __builtin_amdgcn_s_sleep(1);
        if ((++sp & 255u) == 0u) { if (xb_ld(&bar[XB_TMO])) break; if (sp > XB_SPIN_CAP) { atomicAdd(&bar[XB_TMO], 1u); break; } }
    }
    nloc = mine > 0u ? mine : 1u; nx = cnt > 0u ? cnt : 1u;
}

__device__ __forceinline__ void xcd_barrier(const XcdBarrier& b) {
    asm volatile("s_waitcnt vmcnt(0)" ::: "memory");
    __syncthreads();
    if (threadIdx.x == 0) {
        unsigned* bar = b.bar;
        __builtin_amdgcn_s_waitcnt(0);
        unsigned nloc = b.st[0], nx = b.st[1];
        if (nloc == 0u) { xcd_barrier_complete(bar, b.x, nloc, nx); b.st[0] = nloc; b.st[1] = nx; }
        const unsigned old = xb_add(&bar[XB_XSUB(b.x)], 1u);
        const unsigned gen = old / nloc;
        if (old + 1u == (gen + 1u) * nloc) {
            __builtin_amdgcn_fence(__ATOMIC_RELEASE, "agent");
            asm volatile("s_waitcnt vmcnt(0)" ::: "memory");
            const unsigned og = xb_add(&bar[XB_TOP], 1u);
            const unsigned tg = og / nx;
            if (og + 1u == (tg + 1u) * nx) xb_add(&bar[XB_TOPGEN], 1u);
            else XB_SPIN(xb_ld(&bar[XB_TOPGEN]) == tg, bar);
            __builtin_amdgcn_fence(__ATOMIC_ACQUIRE, "agent");
            xb_add(&bar[XB_XGEN(b.x)], 1u);
            asm volatile("s_waitcnt vmcnt(0)" ::: "memory");
        } else {
            XB_SPIN(xb_ld(&bar[XB_XGEN(b.x)]) == gen, bar);
            __builtin_amdgcn_fence(__ATOMIC_ACQUIRE, "agent");
            asm volatile("s_waitcnt vmcnt(0)" ::: "memory");
        }
    }
    __syncthreads();
}

#ifndef PHASE_MASK
#define PHASE_MASK 0xffff
#endif
#ifndef PROBE_ATT
#define PROBE_ATT 1
#endif
#ifndef PROBE_HG
#define PROBE_HG 1
#endif
#ifndef PROBE_P2A
#define PROBE_P2A 1
#endif
#ifndef PROBE_SYNC
#define PROBE_SYNC 1
#endif
#ifndef PROBE_CVT
#define PROBE_CVT 1
#endif
#define GSYNC() do { for (int s_ = 0; s_ < PROBE_SYNC; ++s_) xcd_barrier(xbar); } while (0)
__global__ void __launch_bounds__(NTHR, 2) fwd_megakernel(Ptrs P) {
    extern __shared__ __attribute__((aligned(16))) unsigned char lds_raw[];
    cg::grid_group grid = cg::this_grid();
    LAS unsigned char* lds = (LAS unsigned char*)lds_raw;
    int tid_ = threadIdx.x; asm volatile("" : "+v"(tid_));
    int tid = tid_, lane = tid & 63, wid = __builtin_amdgcn_readfirstlane(tid >> 6);
#define RETID() do { tid_ = threadIdx.x; asm volatile("" : "+v"(tid_)); tid = tid_; lane = tid & 63; wid = __builtin_amdgcn_readfirstlane(tid >> 6); } while (0)
    const int G = gridDim.x, bx = blockIdx.x;
    if (tid_ < 32) ((LAS unsigned*)(lds + 141312))[tid_] = 0u;
    __syncthreads();
    const XcdBarrier xbar = xcd_barrier_post((unsigned*)P.ws, (volatile LAS unsigned*)(lds + 141312 + 32));
    const int NGW = G * NWAVES;
#define gw (bx * NWAVES + wid)
#define WSB() ({ size_t z_ = 0; asm volatile("" : "+s"(z_)); P.ws + z_; })
#define rope ((float*)(WSB() + WS_ROPE))
#define lbs ((float*)(WSB() + WS_LBS))
#define Win_t ((bf16_t*)(WSB() + WS_WIN))
#define Wout_t ((bf16_t*)(WSB() + WS_WOUT))
#define Wgu_t ((bf16_t*)(WSB() + WS_WGU))
#define Wdn_t ((bf16_t*)(WSB() + WS_WDN))
#define xb ((bf16_t*)(WSB() + WS_XB))
#define xres ((float*)(WSB() + WS_XRES))
#define proj ((bf16_t*)(WSB() + WS_PROJ))
#define mixed ((bf16_t*)(WSB() + WS_MIXED))
#define oBp ((bf16_t*)(WSB() + WS_OBP))
#define oA ((float*)(WSB() + WS_OA))
#define lseB ((float*)(WSB() + WS_LSE))
#define gu ((bf16_t*)(WSB() + WS_GU))
#define QTg ((bf16_t*)(WSB() + WS_QT))
#define KHg ((bf16_t*)(WSB() + WS_KH))
#define KTg ((bf16_t*)(WSB() + WS_KT))
#define EBg ((float*)(WSB() + WS_EB))
#define Z (P.out)

    for (int c_ = 0; c_ < PROBE_CVT; ++c_) convert_weights(P, 0, gw, NGW, lane);
    {
        const float* x = P.in[0]; bf16_t* const xb_ = xb; float* const rope_ = rope; float* const lbs_ = lbs;
        for (size_t i = (size_t)bx * NTHR + tid; i < (size_t)M_TOK * DM / 8; i += (size_t)G * NTHR) {
            const f32x4 a = *(const f32x4*)(x + i * 8), c = *(const f32x4*)(x + i * 8 + 4);
            u32x4 w; w.x = pk2(a[0], a[1]); w.y = pk2(a[2], a[3]); w.z = pk2(c[0], c[1]); w.w = pk2(c[2], c[3]);
            *(u32x4*)(xb_ + i * 8) = w; }
        const double CF[16] = {0.15915494309189535, 0.0700865215877985, 0.03086376340470123, 0.013591370636193905, 0.005985185712713705, 0.002635675898667414, 0.001160663641240061, 0.0005111175045375439,
                               0.00022507907903927653, 9.911730936901935e-05, 4.364795279280289e-05, 1.9221100684944863e-05, 8.464330808241401e-06, 3.727408601915352e-06, 1.6414262627950345e-06, 7.228293068832865e-07};
        for (int i = bx * NTHR + tid; i < SEQ * 16; i += G * NTHR) { const int pos = i >> 4, fi = i & 15;
            double cf = CF[0];
#pragma unroll
            for (int q = 1; q < 16; ++q) cf = (fi == q) ? CF[q] : cf;
            double rev = (double)pos * cf; rev -= __builtin_floor(rev); const float rv = (float)rev;
            rope_[pos * 32 + fi] = __builtin_amdgcn_cosf(rv); rope_[pos * 32 + 16 + fi] = __builtin_amdgcn_sinf(rv); }
        if (bx == 0) { const float* lg = P.in[2]; const float l0 = lg[tid], l1 = lg[512 + tid]; lbs_[tid] = 0.f; lbs_[512 + tid] = 1.f / (1.f + __expf(l0 - l1)); }
    }
    grid.sync();

#pragma unroll 1
    for (int l = 0; l < 2; ++l) {
        if (PHASE_MASK & (1 << 1))
        {
            pg8::Gemm g{xb, Win_t, M_TOK, INW, DM, DM}; pg8::StaticOrder S; S.init(M_TOK, INW, G, bx);
            pg8::EpiProj E{proj, INW, rope, QTg, KHg, KTg, EBg, lbs + l * 512};
            pg8::gemm_phase<pg8::EpiProj, pg8::StaticOrder, true, true>(lds, g, S, E);
        }
        GSYNC();
        RETID();
        if (PHASE_MASK & (1 << 2))
        {
            for (int rep_ = 0; rep_ < PROBE_P2A; ++rep_) {
            unsigned char* const wsl = WSB(); bf16_t* const proj_ = (bf16_t*)(wsl + WS_PROJ); bf16_t* const mixed_ = (bf16_t*)(wsl + WS_MIXED); bf16_t* const oBp_ = (bf16_t*)(wsl + WS_OBP); float* const lseB_ = (float*)(wsl + WS_LSE);
            for (int it = bx; it < 64 * PROBE_HG; it += G)
                hgrn_block(lds, (bf16_t*)(wsl + WS_QT), (bf16_t*)(wsl + WS_KH), (bf16_t*)(wsl + WS_KT), (float*)(wsl + WS_EB), proj_, (float*)(wsl + WS_OA), (it & 63) >> 4, (it >> 2) & 3, it & 3, tid, wid, lane);
            {
                const float* sinks = P.in[4] + l * 6;
                unsigned* const ctr = (unsigned*)P.ws + 3600 + l;
                volatile LAS unsigned* const slot = (volatile LAS unsigned*)(lds + 141312 + 64);
                for (;;) {
                    if (tid == 0) slot[0] = __hip_atomic_fetch_add(ctr, 1u, __ATOMIC_RELAXED, __HIP_MEMORY_SCOPE_AGENT);
                    __syncthreads();
                    const int it = (int)slot[0];
                    __syncthreads();
                    if (it >= 1536) break;
                    const int type = it / 384, j = it % 384;
                    int b = j / 96, h = (j % 96) / 16, rr = j % 16;
                    int qcol, kcol, vcol, dil = 1, res = 0, nb = rr, maxlag = 128, ldo = 768, ocol = h * 128; bool hs = false; float sk = 0.f; bf16_t* outp; float* lsep = nullptr;
                    if (type == 0) { qcol = 4352 + h * 128; kcol = 5120 + (h / 3) * 128; vcol = kcol + 256; maxlag = 127; hs = true; sk = sinks[h]; outp = mixed_; ldo = DM; ocol = 1280 + h * 128; }
                    else { const int p = type - 1; qcol = 2048 + h * 128; kcol = qcol + 768; vcol = qcol + 1536;
                        if (p == 1) { dil = 4; res = rr >> 2; nb = rr & 3; } else if (p == 2) { dil = 16; res = rr; nb = 0; }
                        outp = oBp_ + (size_t)p * M_TOK * 768; lsep = lseB_ + (size_t)p * M_TOK * 6 + h; }
                    for (int ra_ = 0; ra_ < PROBE_ATT; ++ra_) attn_item(lds, proj_, b, qcol, kcol, vcol, dil, res, nb, maxlag, hs, sk, outp, ldo, ocol, lsep, tid, wid, lane);
                }
            }
            }
        }
        GSYNC();
        RETID();
        if (PHASE_MASK & (1 << 3))
        {
            const float* nw = P.in[3] + l * 128;
            unsigned char* const wsl = WSB(); const bf16_t* const proj_ = (const bf16_t*)(wsl + WS_PROJ); bf16_t* const mixed_ = (bf16_t*)(wsl + WS_MIXED); const bf16_t* const oBp_ = (const bf16_t*)(wsl + WS_OBP); const float* const lseB_ = (const float*)(wsl + WS_LSE); const float* const oA_ = (const float*)(wsl + WS_OA);
            for (int row = gw; row < M_TOK; row += NGW) {
                { const float* op = oA_ + (size_t)row * 512 + 8 * lane; const f32x4 a = *(const f32x4*)op, c = *(const f32x4*)(op + 4);
                  float ss = (a[0] * a[0] + a[1] * a[1]) + (a[2] * a[2] + a[3] * a[3]) + (c[0] * c[0] + c[1] * c[1]) + (c[2] * c[2] + c[3] * c[3]);
                  ss += __shfl_xor(ss, 1); ss += __shfl_xor(ss, 2); ss += __shfl_xor(ss, 4); ss += __shfl_xor(ss, 8);
                  const float rstd = 1.f / sqrtf(ss * (1.f / 128.f) + LN_EPS);
                  const u32x4 gv = *(const u32x4*)(proj_ + (size_t)row * INW + 1536 + 8 * lane);
                  const f32x4 n0 = *(const f32x4*)(nw + (8 * lane & 127)), n1 = *(const f32x4*)(nw + (8 * lane & 127) + 4);
                  float o[8];
#pragma unroll
                  for (int i = 0; i < 8; ++i) { const float gg = __uint_as_float((i & 1) ? (gv[i >> 1] & 0xffff0000u) : (gv[i >> 1] << 16)); const float ov = (i < 4 ? a[i] : c[i - 4]), nn = (i < 4 ? n0[i] : n1[i - 4]);
                      o[i] = ov * rstd * nn * (gg / (1.f + __expf(-gg))); }
                  u32x4 w; w.x = pk2(o[0], o[1]); w.y = pk2(o[2], o[3]); w.z = pk2(o[4], o[5]); w.w = pk2(o[6], o[7]);
                  *(u32x4*)(mixed_ + (size_t)row * DM + 8 * lane) = w; }
#pragma unroll
                for (int rep = 0; rep < 2; ++rep) { const int chn = lane + 64 * rep;
                    if (chn < 96) { const int h = chn >> 4;
                        const float l0 = lseB_[(size_t)row * 6 + h], l1 = lseB_[((size_t)M_TOK + row) * 6 + h], l2 = lseB_[((size_t)2 * M_TOK + row) * 6 + h];
                        const float mm = fmaxf(l0, fmaxf(l1, l2)); float w0 = __expf(l0 - mm), w1 = __expf(l1 - mm), w2 = __expf(l2 - mm); const float iw = 1.f / (w0 + w1 + w2); w0 *= iw; w1 *= iw; w2 *= iw;
                        const u32x4 a = *(const u32x4*)(oBp_ + (size_t)row * 768 + 8 * chn), c = *(const u32x4*)(oBp_ + ((size_t)M_TOK + row) * 768 + 8 * chn), d = *(const u32x4*)(oBp_ + ((size_t)2 * M_TOK + row) * 768 + 8 * chn);
                        u32x4 w;
#pragma unroll
                        for (int q = 0; q < 4; ++q) { const float lo = w0 * __uint_as_float(a[q] << 16) + w1 * __uint_as_float(c[q] << 16) + w2 * __uint_as_float(d[q] << 16);
                            const float hi = w0 * __uint_as_float(a[q] & 0xffff0000u) + w1 * __uint_as_float(c[q] & 0xffff0000u) + w2 * __uint_as_float(d[q] & 0xffff0000u); w[q] = pk2(lo, hi); }
                        *(u32x4*)(mixed_ + (size_t)row * DM + 512 + 8 * chn) = w; } }
            }
        }
        GSYNC();
        if (PHASE_MASK & (1 << 4))
        {
            pg8::Gemm g{mixed, Wout_t, M_TOK, DM, DM, DM}; pg8::StaticOrder S; S.init(M_TOK, DM, G, bx);
            pg8::EpiZ E{(l == 0) ? P.in[0] : (const float*)xres, Z, ALPHA};
            pg8::gemm_phase<pg8::EpiZ, pg8::StaticOrder, true, true>(lds, g, S, E);
        }
        GSYNC();
        RETID();
        { float* const xres_ = xres; bf16_t* const xb_ = xb; for (int row = gw; row < M_TOK; row += NGW) ln_row(Z + (size_t)row * DM, P.in[6] + l * DM, P.in[7] + l * DM, xres_ + (size_t)row * DM, xb_ + (size_t)row * DM, lane); }
        GSYNC();
        if (PHASE_MASK & (1 << 5))
        {
            pg8::Gemm g{xb, Wgu_t, M_TOK, GUW, DM, DM}; pg8::StaticOrder S; S.init(M_TOK, GUW, G, bx);
            pg8::EpiStore E{gu, GUW};
            pg8::gemm_phase<pg8::EpiStore, pg8::StaticOrder, true, true>(lds, g, S, E);
        }
        GSYNC();
        RETID();
        if (PHASE_MASK & (1 << 6))
        {
            const float* cw = P.in[10] + (size_t)l * 3 * FF; const float* cb = P.in[11] + (size_t)l * FF; bf16_t* const gu_ = gu;
            for (int it = gw; it < 256 * 11; it += NGW) { const int rb = it / 11, cgp = it % 11, c0 = 512 * cgp + 8 * lane, m0 = 32 * rb;
                float w0[8], w1[8], w2[8], bb[8], g2[8], g1[8];
#pragma unroll
                for (int i = 0; i < 8; ++i) { w0[i] = cw[c0 + i]; w1[i] = cw[FF + c0 + i]; w2[i] = cw[2 * FF + c0 + i]; bb[i] = cb[c0 + i]; g2[i] = 0.f; g1[i] = 0.f; }
                if ((m0 & (SEQ - 1)) != 0) { const u32x4 a = *(const u32x4*)(gu_ + (size_t)(m0 - 2) * GUW + c0), c = *(const u32x4*)(gu_ + (size_t)(m0 - 1) * GUW + c0);
#pragma unroll
                    for (int q = 0; q < 4; ++q) { g2[2 * q] = __uint_as_float(a[q] << 16); g2[2 * q + 1] = __uint_as_float(a[q] & 0xffff0000u); g1[2 * q] = __uint_as_float(c[q] << 16); g1[2 * q + 1] = __uint_as_float(c[q] & 0xffff0000u); } }
#pragma unroll 4
                for (int i = 0; i < 32; ++i) { bf16_t* rp = gu_ + (size_t)(m0 + i) * GUW + c0; const u32x4 a = *(const u32x4*)rp, uu = *(const u32x4*)(rp + FF);
                    float g0[8], hh[8];
#pragma unroll
                    for (int q = 0; q < 4; ++q) { g0[2 * q] = __uint_as_float(a[q] << 16); g0[2 * q + 1] = __uint_as_float(a[q] & 0xffff0000u); }
#pragma unroll
                    for (int q = 0; q < 8; ++q) { const float gc = bb[q] + w0[q] * g2[q] + w1[q] * g1[q] + w2[q] * g0[q]; const float uv = __uint_as_float((q & 1) ? (uu[q >> 1] & 0xffff0000u) : (uu[q >> 1] << 16));
                        hh[q] = gc / (1.f + __expf(-gc)) * uv; g2[q] = g1[q]; g1[q] = g0[q]; }
                    u32x4 w; w.x = pk2(hh[0], hh[1]); w.y = pk2(hh[2], hh[3]); w.z = pk2(hh[4], hh[5]); w.w = pk2(hh[6], hh[7]);
                    *(u32x4*)(rp + FF) = w; }
            }
        }
        GSYNC();
        if (PHASE_MASK & (1 << 7))
        {
            pg8::Gemm g{gu + FF, Wdn_t, M_TOK, DM, FF, GUW}; pg8::StaticOrder S; S.init(M_TOK, DM, G, bx);
            pg8::EpiZ E{xres, Z, ALPHA};
            pg8::gemm_phase<pg8::EpiZ, pg8::StaticOrder, true, true>(lds, g, S, E);
        }
        GSYNC();
        RETID();
        if (l == 0) {
            { float* const xres_ = xres; bf16_t* const xb_ = xb; for (int row = gw; row < M_TOK; row += NGW) ln_row(Z + (size_t)row * DM, P.in[13], P.in[14], xres_ + (size_t)row * DM, xb_ + (size_t)row * DM, lane); }
            convert_weights(P, 1, gw, NGW, lane);
            GSYNC();
        } else {
            for (int row = gw; row < M_TOK; row += NGW) ln_row(Z + (size_t)row * DM, P.in[13] + DM, P.in[14] + DM, Z + (size_t)row * DM, nullptr, lane);
        }
    }
}

extern "C" void kernel_launch(void* const* d_in, const int* in_sizes, int n_in, void* d_out, int out_size, void* d_ws, size_t ws_size, hipStream_t stream) {
    static int grid_blocks = 0;
    if (grid_blocks == 0) {
        if (n_in != 15 || ws_size < WS_END) { fprintf(stderr, "kernel_launch: unexpected n_in %d / ws_size %zu\n", n_in, ws_size); grid_blocks = -1; return; }
        int dev = 0, cus = 0, per_cu = 0;
        hipGetDevice(&dev); hipDeviceGetAttribute(&cus, hipDeviceAttributeMultiprocessorCount, dev);
        hipFuncSetAttribute((const void*)fwd_megakernel, hipFuncAttributeMaxDynamicSharedMemorySize, LDS_BYTES);
        hipOccupancyMaxActiveBlocksPerMultiprocessor(&per_cu, (const void*)fwd_megakernel, NTHR, LDS_BYTES);
        if (per_cu < 1) { fprintf(stderr, "kernel_launch: occupancy query says %d blocks/CU\n", per_cu); per_cu = 1; }
        grid_blocks = cus;
        (void)hipGetLastError();
    }
    if (grid_blocks < 0) return;
    if (hipMemsetAsync(d_ws, 0, 16384, stream) != hipSuccess) { fprintf(stderr, "memset failed\n"); return; }
    Ptrs p{};
    for (int i = 0; i < 15; ++i) p.in[i] = (const float*)d_in[i];
    p.out = (float*)d_out; p.ws = (unsigned char*)d_ws;
    void* args[] = {&p};
    hipError_t e = hipLaunchCooperativeKernel((const void*)fwd_megakernel, dim3(grid_blocks), dim3(NTHR), args, LDS_BYTES, stream);
    if (e != hipSuccess) fprintf(stderr, "cooperative launch failed: %s (grid %d)\n", hipGetErrorString(e), grid_blocks);
}
```
